# Optimizing an MI355X kernel written in HIP

```python
import math
import jax, jax.numpy as jnp
from jax import lax
import numpy as np

D_MODEL = 1024
BATCH = 4
SEQ = 8192
DEPTH = 2

GRID_W = 64
HEAD_DIM = 128
ATTN_WIDTH = D_MODEL
N_HEADS = ATTN_WIDTH // HEAD_DIM
N_KV_HEADS = 2
GROUP = N_HEADS // N_KV_HEADS
KV_WIDTH = N_KV_HEADS * HEAD_DIM
Q_BLOCK = 128
ROPE_THETA = 10000.0
ROPE_HALF = HEAD_DIM // 2
POOL_WINDOWS = (2, 4, 8, 16)
N_POOL_GROUPS = 4
POOL_WIDTH = D_MODEL // 2
POOL_GROUP_DIM = POOL_WIDTH // N_POOL_GROUPS
IN_COLS = ATTN_WIDTH + 2 * KV_WIDTH + POOL_WIDTH + 2 * D_MODEL
N_PEER_HEADS = 8
PEER_QUERY_DIM = 512
SUBKEY_DIM = PEER_QUERY_DIM // 2
N_KEYS = 128
N_EXPERTS = N_KEYS * N_KEYS
PEER_TOPK = 16
TOKEN_BLOCK = 128
N_ADA = 6
EPS = 1e-6

kernel_name = "hybrid_gqa_pool_peer_encoder"


def rms_norm(x, w):
    xf = x.astype(jnp.float32)
    y = xf * lax.rsqrt(jnp.mean(xf * xf, axis=-1, keepdims=True) + EPS)
    return (y * w.astype(jnp.float32)).astype(x.dtype)


def modulate(xn, shift, scale):
    return xn * (1.0 + scale[:, None, :]) + shift[:, None, :]


def axial_rope_angles(seq_len):
    rows = seq_len // GRID_W
    t = jnp.arange(rows * GRID_W)
    row = (t // GRID_W).astype(jnp.float32)
    col = (t % GRID_W).astype(jnp.float32)
    inv = 1.0 / (ROPE_THETA ** (jnp.arange(0, ROPE_HALF, 2, dtype=jnp.float32) / ROPE_HALF))
    return row[:, None] * inv, col[:, None] * inv


def rotate_half_dims(xh, ang):
    half = ROPE_HALF // 2
    cos = jnp.cos(ang)[None, :, None, :]
    sin = jnp.sin(ang)[None, :, None, :]
    xf = xh.astype(jnp.float32)
    x1, x2 = xf[..., :half], xf[..., half:]
    return jnp.concatenate([x1 * cos - x2 * sin, x2 * cos + x1 * sin], axis=-1).astype(xh.dtype)


def apply_axial_rope(x, ang_r, ang_c):
    return jnp.concatenate([rotate_half_dims(x[..., :ROPE_HALF], ang_r),
                            rotate_half_dims(x[..., ROPE_HALF:], ang_c)], axis=-1)


def blocked_bidirectional_gqa(q, k, v):
    B, S = q.shape[0], q.shape[1]
    nb = S // Q_BLOCK
    scale = 1.0 / math.sqrt(HEAD_DIM)
    qb = q.reshape(B, nb, Q_BLOCK, N_KV_HEADS, GROUP, HEAD_DIM).swapaxes(0, 1)

    def one_block(qblk):
        s = jnp.einsum('bqkgd,bskd->bkgqs', qblk, k).astype(jnp.float32) * scale
        p = jax.nn.softmax(s, axis=-1).astype(v.dtype)
        return jnp.einsum('bkgqs,bskd->bqkgd', p, v)

    ob = lax.map(one_block, qb)
    return ob.swapaxes(0, 1).reshape(B, S, N_HEADS * HEAD_DIM)


def multiscale_pool(u, pool_mix_w, pool_scale):
    B, S, _ = u.shape
    ug = u.reshape(B, S, N_POOL_GROUPS, POOL_GROUP_DIM).astype(jnp.float32)
    t = jnp.arange(S)
    outs = []
    for gi, w in enumerate(POOL_WINDOWS):
        xg = ug[:, :, gi, :]
        csum = jnp.concatenate([jnp.zeros((B, 1, POOL_GROUP_DIM), jnp.float32),
                                jnp.cumsum(xg, axis=1)], axis=1)
        lo = jnp.clip(t - w // 2, 0, S)
        hi = jnp.clip(t + w // 2, 0, S)
        cnt = (hi - lo).astype(jnp.float32)[None, :, None]
        outs.append((csum[:, hi] - csum[:, lo]) / cnt - xg)
    m = jnp.stack(outs, axis=2).astype(u.dtype)
    mixed = jnp.einsum('bsgc,gcd->bsgd', m, pool_mix_w).reshape(B, S, POOL_WIDTH)
    return mixed * pool_scale


def peer_ffn(xm, w_query, sub_keys, expert_u, expert_v):
    B, S, D = xm.shape
    nb = S // TOKEN_BLOCK
    xb = xm.reshape(B, nb, TOKEN_BLOCK, D).swapaxes(0, 1)

    def one_block(xblk):
        q = (xblk @ w_query).reshape(B, TOKEN_BLOCK, N_PEER_HEADS, 2, SUBKEY_DIM)
        s = jnp.einsum('bthpd,hpnd->bthpn', q, sub_keys).astype(jnp.float32)
        vals, idx = lax.top_k(s, PEER_TOPK)
        cand = (vals[..., 0, :, None] + vals[..., 1, None, :]).reshape(B, TOKEN_BLOCK, N_PEER_HEADS, PEER_TOPK * PEER_TOPK)
        cand_idx = (idx[..., 0, :, None] * N_KEYS + idx[..., 1, None, :]).reshape(B, TOKEN_BLOCK, N_PEER_HEADS, PEER_TOPK * PEER_TOPK)
        top_s, pos = lax.top_k(cand, PEER_TOPK)
        eidx = jnp.take_along_axis(cand_idx, pos, axis=-1)
        g = jax.nn.softmax(top_s, axis=-1).astype(xblk.dtype)
        u = expert_u[eidx]
        h = jnp.einsum('btd,bthkd->bthk', xblk, u)
        act = jax.nn.gelu(h, approximate=False) * g
        return jnp.einsum('bthk,bthkd->btd', act, expert_v[eidx])

    yb = lax.map(one_block, xb)
    return yb.swapaxes(0, 1).reshape(B, S, D)


def setup_inputs(seed: int = 0) -> dict:
    key = jax.random.key(seed)
    ks = jax.random.split(key, 20)
    f32 = jnp.float32
    nrm = lambda k, shape, s: (jax.random.normal(k, shape, f32) * s)
    return {
        "x": nrm(ks[0], (BATCH, SEQ, D_MODEL), 1.0),
        "c": nrm(ks[1], (BATCH, D_MODEL), 1.0),
        "ada_w": nrm(ks[2], (DEPTH, D_MODEL, N_ADA * D_MODEL), 0.5 * D_MODEL ** -0.5),
        "ada_b": nrm(ks[3], (DEPTH, N_ADA * D_MODEL), 0.01),
        "norm_mix_w": 1.0 + nrm(ks[4], (DEPTH, D_MODEL), 0.05),
        "w_in": nrm(ks[5], (DEPTH, D_MODEL, IN_COLS), D_MODEL ** -0.5),
        "q_norm_w": 1.0 + nrm(ks[6], (DEPTH, HEAD_DIM), 0.05),
        "k_norm_w": 1.0 + nrm(ks[7], (DEPTH, HEAD_DIM), 0.05),
        "w_attn_o": nrm(ks[8], (DEPTH, ATTN_WIDTH, D_MODEL), ATTN_WIDTH ** -0.5),
        "pool_mix_w": nrm(ks[9], (DEPTH, N_POOL_GROUPS, POOL_GROUP_DIM, POOL_GROUP_DIM), POOL_GROUP_DIM ** -0.5),
        "pool_scale": 1.0 + nrm(ks[10], (DEPTH, POOL_WIDTH), 0.05),
        "w_pool_o": nrm(ks[11], (DEPTH, POOL_WIDTH, D_MODEL), POOL_WIDTH ** -0.5),
        "w_out": nrm(ks[12], (DEPTH, D_MODEL, D_MODEL), D_MODEL ** -0.5),
        "norm_ffn_w": 1.0 + nrm(ks[13], (DEPTH, D_MODEL), 0.05),
        "w_query": nrm(ks[14], (DEPTH, D_MODEL, N_PEER_HEADS * PEER_QUERY_DIM), D_MODEL ** -0.5),
        "sub_keys": nrm(ks[15], (DEPTH, N_PEER_HEADS, 2, N_KEYS, SUBKEY_DIM), SUBKEY_DIM ** -0.5),
        "expert_u": nrm(ks[16], (DEPTH, N_EXPERTS, D_MODEL), D_MODEL ** -0.5),
        "expert_v": nrm(ks[17], (DEPTH, N_EXPERTS, D_MODEL), N_PEER_HEADS ** -0.5),
        "final_norm_w": 1.0 + nrm(ks[18], (D_MODEL,), 0.05),
    }


def reference(x, c, ada_w, ada_b, norm_mix_w, w_in, q_norm_w, k_norm_w, w_attn_o, pool_mix_w,
              pool_scale, w_pool_o, w_out, norm_ffn_w, w_query, sub_keys, expert_u, expert_v,
              final_norm_w):
    B, S, _ = x.shape
    ang_r, ang_c = axial_rope_angles(S)
    c_act = jax.nn.silu(c)
    splits = [ATTN_WIDTH, ATTN_WIDTH + KV_WIDTH, ATTN_WIDTH + 2 * KV_WIDTH,
              ATTN_WIDTH + 2 * KV_WIDTH + POOL_WIDTH, ATTN_WIDTH + 2 * KV_WIDTH + POOL_WIDTH + D_MODEL]
    for l in range(DEPTH):
        mod = c_act @ ada_w[l] + ada_b[l]
        sh1, sc1, g1, sh2, sc2, g2 = jnp.split(mod, N_ADA, axis=-1)

        xm = modulate(rms_norm(x, norm_mix_w[l]), sh1, sc1)
        proj = xm @ w_in[l]
        q, k, v, u_pool, ga, gp = jnp.split(proj, splits, axis=-1)

        q = rms_norm(q.reshape(B, S, N_HEADS, HEAD_DIM), q_norm_w[l])
        k = rms_norm(k.reshape(B, S, N_KV_HEADS, HEAD_DIM), k_norm_w[l])
        v = v.reshape(B, S, N_KV_HEADS, HEAD_DIM)
        q = apply_axial_rope(q, ang_r, ang_c).reshape(B, S, N_KV_HEADS, GROUP, HEAD_DIM)
        k = apply_axial_rope(k, ang_r, ang_c)
        attn = blocked_bidirectional_gqa(q, k, v) @ w_attn_o[l]

        pool = multiscale_pool(u_pool, pool_mix_w[l], pool_scale[l]) @ w_pool_o[l]

        merged = jax.nn.sigmoid(ga) * attn + jax.nn.sigmoid(gp) * pool
        x = x + g1[:, None, :] * (merged @ w_out[l])

        xf = modulate(rms_norm(x, norm_ffn_w[l]), sh2, sc2)
        x = x + g2[:, None, :] * peer_ffn(xf, w_query[l], sub_keys[l], expert_u[l], expert_v[l])

    return rms_norm(x, final_norm_w)
```

```cpp
#include <hip/hip_runtime.h>
#include <cstdio>
#include <cstdint>
#include <cstring>

#ifndef MK_ONE_LAUNCH
#define MK_ONE_LAUNCH 0
#endif

constexpr int DM = 1024, NB = 4, SEQ = 8192, TOK = NB * SEQ, DEPTH = 2;
constexpr int HD = 128, NH = 8, NKV = 2, KVW = 256, POOLW = 512, INC = 4096;
constexpr int PH = 8, PQD = 512, SUBD = 256, NKEYS = 128, NEXP = 16384, TOPK = 16;
constexpr int NADA = 6;
constexpr float EPS = 1e-6f;

constexpr size_t MiB = 1u << 20;
constexpr size_t WS_CTL = 0, CTL_ZERO_BYTES = 64 * 1024;
constexpr size_t WS_MOD = 1 * MiB;
constexpr size_t WS_ROPE = WS_MOD + 256 * 1024;
constexpr size_t WS_WIN = 2 * MiB;
constexpr size_t WS_WAO = WS_WIN + 16 * MiB;
constexpr size_t WS_WPO = WS_WAO + 4 * MiB;
constexpr size_t WS_WOUT = WS_WPO + 2 * MiB;
constexpr size_t WS_WQ = WS_WOUT + 4 * MiB;
constexpr size_t WS_SUBK = WS_WQ + 16 * MiB;
constexpr size_t WS_WMIX = WS_SUBK + 2 * MiB;
constexpr size_t WS_EXPU = 48 * MiB;
constexpr size_t WS_EXPV = WS_EXPU + 32 * MiB;
constexpr size_t WS_XN = 112 * MiB;
constexpr size_t WS_PROJ = 176 * MiB;
constexpr size_t WS_Q = WS_PROJ, WS_K = WS_Q + 64 * MiB, WS_V = WS_K + 16 * MiB, WS_UP = WS_V + 16 * MiB, WS_GA = WS_UP + 32 * MiB, WS_GP = WS_GA + 64 * MiB;
constexpr size_t WS_EIDX = 432 * MiB;
constexpr size_t WS_GS = WS_EIDX + 16 * MiB;
constexpr size_t WS_END = WS_GS + 16 * MiB;
static_assert(WS_WMIX + 1 * MiB <= WS_EXPU && WS_GP + 64 * MiB == WS_EIDX, "d_ws map");

namespace pg8 {
#define PG8_LAS __attribute__((address_space(3)))
typedef unsigned short bf16_t;
typedef short bf16x8 __attribute__((ext_vector_type(8)));
typedef float f32x4 __attribute__((ext_vector_type(4)));
typedef unsigned u32x4 __attribute__((ext_vector_type(4)));
constexpr int BM = 256, BK = 64, HALF = 128, HTB = HALF * BK * 2  , STAGE_BYTES = 8 * HTB, NXCD = 8, WGM = 8;

__host__ __device__ __forceinline__ int lds_byte(int r, int c) { const int st = (r >> 4) * 2 + (c >> 5), rr = r & 15, cc = c & 31, ob = rr * 64 + cc * 2; return st * 1024 + (ob ^ (((ob >> 9) & 1) << 5)); }
__host__ __device__ __forceinline__ void stage_rc(int b, int& R, int& C) { const int st = b / 1024, sb = b % 1024, swz = sb ^ (((sb >> 9) & 1) << 5); R = (st >> 1) * 16 + swz / 64; C = (st & 1) * 32 + (swz % 64) / 2; }
__host__ __device__ __forceinline__ int perm32(int rho) { const int n = rho >> 4, i = rho & 15; return 8 * (i >> 2) + 4 * n + (i & 3); }

struct Unit { int pm, pn; };
struct Gemm { const bf16_t* A; const bf16_t* Bt; int M, N, K; };

struct StaticOrder {
    int nM, nN, nwg, G, c;
    __host__ __device__ void init(int M, int N, int G_, int c_) { nM = M / BM; nN = N / BM; nwg = nM * nN; G = G_; c = c_; }
    __host__ __device__ bool next(int i, Unit& u) const {
        const long L = (long)i * G + c; if (L >= nwg) return false;
        int wgid = (int)L; { const int q = nwg / NXCD, r = nwg % NXCD, xcd = wgid % NXCD, off = wgid / NXCD; wgid = (xcd < r ? xcd * (q + 1) : r * (q + 1) + (xcd - r) * q) + off; }
        const int nig = WGM * nN, gid = wgid / nig, fm = gid * WGM, gsz = (nM - fm) < WGM ? (nM - fm) : WGM;
        u.pm = fm + ((wgid % nig) % gsz); u.pn = (wgid % nig) / gsz; return true;
    }
    __device__ __forceinline__ void a_ready(const Unit&) const {}
    __device__ __forceinline__ void done(const Unit&) const {}
};

__device__ __forceinline__ unsigned cvt_pk_bf16(float lo, float hi) { unsigned r; asm volatile("v_cvt_pk_bf16_f32 %0, %1, %2" : "=v"(r) : "v"(lo), "v"(hi)); return r; }
__device__ __forceinline__ float bflo(unsigned w) { return __builtin_bit_cast(float, w << 16); }
__device__ __forceinline__ float bfhi(unsigned w) { return __builtin_bit_cast(float, w & 0xffff0000u); }
__device__ __forceinline__ float sigm(float x) { return __builtin_amdgcn_rcpf(1.f + __expf(-x)); }

template <int MODE> struct EpiB {
    static constexpr bool PERM = true, AFTER_DRAIN = false;
    bf16_t* O; int ldc; const bf16_t* T1; const float* scale;
    bf16_t *pq, *pk, *pv, *pup, *pga, *pgp;
    __device__ __forceinline__ void operator()(const f32x4 (&acc)[2][2][4][2], const Unit& u, int wr, int wc, int fr, int fq) const {
        const int row0 = u.pm * BM + wr * 64 + fr; int colt = u.pn * BM; bf16_t* base = O; int ld = ldc;
        if (MODE == 1) {
            const int pn = u.pn;
            if (pn < 4) { base = pq; ld = 1024; colt = pn * 256; }
            else if (pn == 4) { base = pk; ld = 256; colt = 0; }
            else if (pn == 5) { base = pv; ld = 256; colt = 0; }
            else if (pn < 8) { base = pup; ld = 512; colt = (pn - 6) * 256; }
            else if (pn < 12) { base = pga; ld = 1024; colt = (pn - 8) * 256; }
            else { base = pgp; ld = 1024; colt = (pn - 12) * 256; }
        }
        const int col0 = colt + wc * 32 + 8 * fq;
        f32x4 sv[2][2];
        if (MODE == 3) {
#pragma unroll
            for (int bj = 0; bj < 2; ++bj)
#pragma unroll
                for (int n = 0; n < 2; ++n) sv[bj][n] = *(const f32x4*)(scale + col0 + bj * HALF + 4 * n);
        }
#pragma unroll
        for (int ai = 0; ai < 2; ++ai)
#pragma unroll
            for (int m = 0; m < 4; ++m) {
                const size_t roff = (size_t)(row0 + ai * HALF + m * 16) * ld + col0;
#pragma unroll
                for (int bj = 0; bj < 2; ++bj) {
                    f32x4 v0 = acc[ai][bj][m][0], v1 = acc[ai][bj][m][1];
                    bf16_t* p = base + roff + bj * HALF;
                    if (MODE == 3) { v0 = v0 * sv[bj][0]; v1 = v1 * sv[bj][1]; }
                    if (MODE == 2 || MODE == 4) {
                        const u32x4 g = *(const u32x4*)p;
                        v0[0] *= sigm(bflo(g.x)); v0[1] *= sigm(bfhi(g.x)); v0[2] *= sigm(bflo(g.y)); v0[3] *= sigm(bfhi(g.y));
                        v1[0] *= sigm(bflo(g.z)); v1[1] *= sigm(bfhi(g.z)); v1[2] *= sigm(bflo(g.w)); v1[3] *= sigm(bfhi(g.w));
                    }
                    if (MODE == 4) {
                        const u32x4 t = *(const u32x4*)(T1 + roff + bj * HALF);
                        v0[0] += bflo(t.x); v0[1] += bfhi(t.x); v0[2] += bflo(t.y); v0[3] += bfhi(t.y);
                        v1[0] += bflo(t.z); v1[1] += bfhi(t.z); v1[2] += bflo(t.w); v1[3] += bfhi(t.w);
                    }
                    u32x4 w; w.x = cvt_pk_bf16(v0[0], v0[1]); w.y = cvt_pk_bf16(v0[2], v0[3]); w.z = cvt_pk_bf16(v1[0], v1[1]); w.w = cvt_pk_bf16(v1[2], v1[3]);
                    *(u32x4*)p = w;
                }
            }
    }
};

struct EpiResid {
    static constexpr bool PERM = false, AFTER_DRAIN = false;
    const float* Xin; float* Xout; const float* gate;
    __device__ __forceinline__ void operator()(const f32x4 (&acc)[2][2][4][2], const Unit& u, int wr, int wc, int fr, int fq) const {
        const int row0 = u.pm * BM + wr * 64 + fr, colb = u.pn * BM + wc * 32 + 4 * fq;
        const float* gp = gate + (size_t)((u.pm * BM) >> 13) * 6144;
        f32x4 gv[2][2];
#pragma unroll
        for (int bj = 0; bj < 2; ++bj)
#pragma unroll
            for (int n = 0; n < 2; ++n) gv[bj][n] = *(const f32x4*)(gp + colb + bj * HALF + 16 * n);
#pragma unroll
        for (int ai = 0; ai < 2; ++ai)
#pragma unroll
            for (int m = 0; m < 4; ++m) {
                const size_t roff = (size_t)(row0 + ai * HALF + m * 16) * 1024 + colb;
#pragma unroll
                for (int bj = 0; bj < 2; ++bj)
#pragma unroll
                    for (int n = 0; n < 2; ++n) {
                        const f32x4 xi = *(const f32x4*)(Xin + roff + bj * HALF + 16 * n);
                        *(f32x4*)(Xout + roff + bj * HALF + 16 * n) = xi + gv[bj][n] * acc[ai][bj][m][n];
                    }
            }
    }
};

template <class Epi, class Sched, bool ALIGN_EPI = false, bool SP2 = false>
__device__ __forceinline__ void gemm_phase(PG8_LAS unsigned char* lds, const Gemm g, const Sched& S, const Epi& E) {
    int tid = threadIdx.x; asm volatile("" : "+v"(tid));
    const int wid = __builtin_amdgcn_readfirstlane(tid >> 6), lane = tid & 63, wr = wid >> 2, wc = wid & 3, fr = lane & 15, fq = lane >> 4;
    const int K = g.K, nt = K / BK;
    unsigned voffA[2], voffB[2];
#pragma unroll
    for (int i = 0; i < 2; ++i) { int R, C; stage_rc(tid * 16 + i * 8192, R, C); const int Rb = Epi::PERM ? ((R & ~31) + perm32(R & 31)) : R;
        voffA[i] = (unsigned)(R * K + C) * 2u; voffB[i] = (unsigned)(Rb * K + C) * 2u; }
    const size_t kstep = (size_t)(BK * 2);
    const size_t hstep = (size_t)HALF * K * 2;
    const size_t tstep = 2 * hstep;
    const unsigned ldsw = (unsigned)wid * 1024u;
    const int aoff = lds_byte(wr * 64 + fr, fq * 8), boff = lds_byte(wc * 32 + fr, fq * 8);
#define PG8_SA(b, h) (((b) * 2 + (h)) * HTB)
#define PG8_SB(b, h) ((4 + (b) * 2 + (h)) * HTB)
#define PG8_STAGE(bufoff, gbase, voff) do { _Pragma("unroll") for (int _i = 0; _i < 2; ++_i) \
        __builtin_amdgcn_global_load_lds((const unsigned*)((const char*)(gbase) + (voff)[_i]), (PG8_LAS unsigned*)(lds + (bufoff) + ldsw + _i * 8192), 16, 0, 0); } while (0)
#define PG8_LDA(dst, b, h) do { _Pragma("unroll") for (int m = 0; m < 4; ++m) _Pragma("unroll") for (int k = 0; k < 2; ++k) dst[m][k] = *(const PG8_LAS bf16x8*)(lds + PG8_SA(b, h) + aoff + m * 2048 + k * 1024); } while (0)
#define PG8_LDB(dst, b, h) do { _Pragma("unroll") for (int n = 0; n < 2; ++n) _Pragma("unroll") for (int k = 0; k < 2; ++k) dst[n][k] = *(const PG8_LAS bf16x8*)(lds + PG8_SB(b, h) + boff + n * 2048 + k * 1024); } while (0)
#define PG8_MMA(ai, bj, At, Bt) do { __builtin_amdgcn_s_setprio(1); _Pragma("unroll") for (int m = 0; m < 4; ++m) _Pragma("unroll") for (int n = 0; n < 2; ++n) _Pragma("unroll") for (int k = 0; k < 2; ++k) \
        acc[ai][bj][m][n] = __builtin_amdgcn_mfma_f32_16x16x32_bf16(Bt[n][k], At[m][k], acc[ai][bj][m][n], 0, 0, 0); __builtin_amdgcn_s_setprio(0); } while (0)
#define PG8_WAIT_V(n) asm volatile("s_waitcnt vmcnt(" #n ")" ::: "memory")
#define PG8_WAIT_L(n) asm volatile("s_waitcnt lgkmcnt(" #n ")" ::: "memory")
#define PG8_BAR __builtin_amdgcn_s_barrier()
#define PG8_SCHED __builtin_amdgcn_sched_barrier(0)
    Unit cur, nxt; int ui = 0;
    if (!S.next(0, cur)) return;
    f32x4 acc[2][2][4][2];
#pragma unroll
    for (int a = 0; a < 2; ++a)
#pragma unroll
        for (int b = 0; b < 2; ++b)
#pragma unroll
            for (int m = 0; m < 4; ++m)
#pragma unroll
                for (int n = 0; n < 2; ++n) acc[a][b][m][n] = (f32x4){0.f, 0.f, 0.f, 0.f};
    bf16x8 At[4][2], B0[2][2], B1[2][2];
    const char* cA = (const char*)g.A + (size_t)cur.pm * tstep; const char* cB = (const char*)g.Bt + (size_t)cur.pn * tstep;
    S.a_ready(cur);
    if constexpr (SP2) {
        PG8_STAGE(PG8_SB(0, 0), cB, voffB); PG8_STAGE(PG8_SB(0, 1), cB + hstep, voffB); PG8_STAGE(PG8_SA(0, 0), cA, voffA); PG8_STAGE(PG8_SA(0, 1), cA + hstep, voffA);
        if (wr == 1) PG8_BAR;
        PG8_WAIT_V(2); PG8_BAR;
        PG8_STAGE(PG8_SB(1, 0), cB + kstep, voffB); PG8_STAGE(PG8_SA(1, 0), cA + kstep, voffA); PG8_STAGE(PG8_SB(1, 1), cB + hstep + kstep, voffB);
        PG8_WAIT_V(6); PG8_BAR;
    } else {
        PG8_STAGE(PG8_SB(0, 0), cB, voffB); PG8_STAGE(PG8_SA(0, 0), cA, voffA); PG8_STAGE(PG8_SB(0, 1), cB + hstep, voffB); PG8_STAGE(PG8_SA(0, 1), cA + hstep, voffA);
        if (wr == 1) PG8_BAR;
        PG8_WAIT_V(4); PG8_BAR;
        PG8_STAGE(PG8_SB(1, 0), cB + kstep, voffB); PG8_STAGE(PG8_SA(1, 0), cA + kstep, voffA); PG8_STAGE(PG8_SB(1, 1), cB + hstep + kstep, voffB);
        PG8_WAIT_V(6); PG8_BAR;
    }
    for (;;) {
        const bool has_next = S.next(ui + 1, nxt);
        const char* nA = has_next ? (const char*)g.A + (size_t)nxt.pm * tstep : cA; const char* nB = has_next ? (const char*)g.Bt + (size_t)nxt.pn * tstep : cB;
        for (int t = 0; t < nt; t += 2) {
            const bool last = (t == nt - 2);
            const char* a1 = cA + (size_t)(t + 1) * kstep;
            const char* a2 = last ? nA : cA + (size_t)(t + 2) * kstep; const char* b2 = last ? nB : cB + (size_t)(t + 2) * kstep;
            const char* a3 = a2 + kstep; const char* b3 = b2 + kstep;
            if (last && has_next) S.a_ready(nxt);
            if constexpr (SP2) {
            PG8_LDB(B0, 0, 0); PG8_LDB(B1, 0, 1); PG8_SCHED; PG8_LDA(At, 0, 0); PG8_STAGE(PG8_SA(1, 1), a1 + hstep, voffA);
            PG8_WAIT_V(8); PG8_WAIT_L(0); PG8_BAR; PG8_MMA(0, 0, At, B0); PG8_MMA(0, 1, At, B1); PG8_BAR; PG8_SCHED;
            PG8_LDA(At, 0, 1); PG8_STAGE(PG8_SB(0, 0), b2, voffB); PG8_STAGE(PG8_SB(0, 1), b2 + hstep, voffB); PG8_STAGE(PG8_SA(0, 0), a2, voffA);
            PG8_WAIT_V(8); PG8_WAIT_L(0); PG8_BAR; PG8_MMA(1, 0, At, B0); PG8_MMA(1, 1, At, B1); PG8_BAR; PG8_SCHED;
            PG8_LDB(B0, 1, 0); PG8_LDB(B1, 1, 1); PG8_SCHED; PG8_LDA(At, 1, 0); PG8_STAGE(PG8_SA(0, 1), a2 + hstep, voffA);
            PG8_WAIT_V(8); PG8_WAIT_L(0); PG8_BAR; PG8_MMA(0, 0, At, B0); PG8_MMA(0, 1, At, B1); PG8_BAR; PG8_SCHED;
            PG8_LDA(At, 1, 1); PG8_STAGE(PG8_SB(1, 0), b3, voffB); PG8_STAGE(PG8_SB(1, 1), b3 + hstep, voffB); PG8_STAGE(PG8_SA(1, 0), a3, voffA);
            PG8_WAIT_V(8); PG8_WAIT_L(0); PG8_BAR; PG8_MMA(1, 0, At, B0); PG8_MMA(1, 1, At, B1); PG8_BAR; PG8_SCHED;
            } else {
            PG8_LDB(B0, 0, 0); PG8_SCHED; PG8_LDA(At, 0, 0); PG8_STAGE(PG8_SA(1, 1), a1 + hstep, voffA);
            PG8_WAIT_L(8); PG8_BAR; PG8_WAIT_L(0); PG8_MMA(0, 0, At, B0); PG8_BAR; PG8_SCHED;
            PG8_LDB(B1, 0, 1); PG8_STAGE(PG8_SB(0, 0), b2, voffB);
            PG8_BAR; PG8_WAIT_L(0); PG8_MMA(0, 1, At, B1); PG8_BAR;
            PG8_LDA(At, 0, 1); PG8_STAGE(PG8_SA(0, 0), a2, voffA);
            PG8_BAR; PG8_WAIT_L(0); PG8_MMA(1, 0, At, B0); PG8_BAR; PG8_SCHED;
            PG8_STAGE(PG8_SB(0, 1), b2 + hstep, voffB);
            PG8_WAIT_V(6); PG8_BAR; PG8_MMA(1, 1, At, B1); PG8_BAR;
            PG8_LDB(B0, 1, 0); PG8_SCHED; PG8_LDA(At, 1, 0); PG8_STAGE(PG8_SA(0, 1), a2 + hstep, voffA);
            PG8_WAIT_L(8); PG8_BAR; PG8_WAIT_L(0); PG8_MMA(0, 0, At, B0); PG8_BAR; PG8_SCHED;
            PG8_LDB(B1, 1, 1); PG8_STAGE(PG8_SB(1, 0), b3, voffB);
            PG8_BAR; PG8_WAIT_L(0); PG8_MMA(0, 1, At, B1); PG8_BAR;
            PG8_LDA(At, 1, 1); PG8_STAGE(PG8_SA(1, 0), a3, voffA);
            PG8_BAR; PG8_WAIT_L(0); PG8_MMA(1, 0, At, B0); PG8_BAR; PG8_SCHED;
            PG8_STAGE(PG8_SB(1, 1), b3 + hstep, voffB);
            PG8_WAIT_V(6); PG8_BAR; PG8_MMA(1, 1, At, B1); PG8_BAR;
            }
        }
        if constexpr (ALIGN_EPI) { if (wr == 0) PG8_BAR; }
        if constexpr (!Epi::AFTER_DRAIN) { E(acc, cur, wr, wc, fr, fq); S.done(cur); }
        if (!has_next) break;
#pragma unroll
        for (int a = 0; a < 2; ++a)
#pragma unroll
            for (int b = 0; b < 2; ++b)
#pragma unroll
                for (int m = 0; m < 4; ++m)
#pragma unroll
                    for (int n = 0; n < 2; ++n) acc[a][b][m][n] = (f32x4){0.f, 0.f, 0.f, 0.f};
        cur = nxt; cA = nA; cB = nB; ++ui;
        if constexpr (ALIGN_EPI) { if (wr == 1) PG8_BAR; }
    }
    PG8_WAIT_V(0);
    if constexpr (!ALIGN_EPI) { if (wr == 0) PG8_BAR; }
    PG8_BAR;
    if constexpr (Epi::AFTER_DRAIN) { E.fused(acc, cur, wr, wc, fr, fq, lds, wid, lane); S.done(cur); }
#undef PG8_SA
#undef PG8_SB
#undef PG8_STAGE
#undef PG8_LDA
#undef PG8_LDB
#undef PG8_MMA
#undef PG8_WAIT_V
#undef PG8_WAIT_L
#undef PG8_BAR
#undef PG8_SCHED
}
}
namespace att {
typedef unsigned short bf16;
constexpr int   D = 128, NW = 8, QBLK = 32, KVBLK = 64;
constexpr float SCALE = 0.088388347648318440f;
constexpr float THR = 8.f;
constexpr int SDEPTH = 2;
constexpr int LDQ = 1024, LDK = 256, LDO = 1024;
constexpr size_t SHM_V = KVBLK * D * 2, SHM_K = KVBLK * D * 2, SHM_ATTN = 2 * SHM_V + 2 * SHM_K + NW * 64 * 4;
using bf16x8 = __attribute__((ext_vector_type(8))) short;
using s16x4  = __attribute__((ext_vector_type(4))) short;
using f32x16 = __attribute__((ext_vector_type(16))) float;
using f32x8  = __attribute__((ext_vector_type(8))) float;
using u32x4  = __attribute__((ext_vector_type(4))) unsigned;
#define KSWZ(row, colB) ((row) * 256 + ((colB) ^ (((row) & 7) << 4)))
#define SBAR() __builtin_amdgcn_sched_barrier(0)
__device__ __forceinline__ int crow(int r, int hi) { return (r & 3) + 8 * (r >> 2) + 4 * hi; }
__device__ __forceinline__ unsigned cvtpk(float lo, float hi) {
  unsigned r; asm volatile("v_cvt_pk_bf16_f32 %0, %1, %2" : "=v"(r) : "v"(lo), "v"(hi)); return r;
}
template <typename TIn> struct Stage;
template <> struct Stage<bf16>  { using T = bf16x8;
  __device__ static __forceinline__ T ld8(const bf16* p) { return *reinterpret_cast<const bf16x8*>(p); }
  __device__ static __forceinline__ bf16x8 tobf(T x) { return x; } };

__device__ __forceinline__ void partialSM(f32x16& p0, f32x16& p1, float& m_reg, float& mn, float& alpha) {
  constexpr float C = SCALE * 1.4426950408889634f;
  float pmax = p0[0]; for (int r = 1; r < 16; ++r) pmax = fmaxf(pmax, p0[r]); for (int r = 0; r < 16; ++r) pmax = fmaxf(pmax, p1[r]);
  { auto rr = __builtin_amdgcn_permlane32_swap(__float_as_uint(pmax), __float_as_uint(pmax), false, false);
    pmax = fmaxf(__uint_as_float(rr[0]), __uint_as_float(rr[1])); }
  if (__builtin_expect(__all(pmax - m_reg <= THR / SCALE), 1)) { mn = m_reg; alpha = 1.f; }
  else { mn = fmaxf(m_reg, pmax); alpha = __builtin_amdgcn_exp2f((m_reg - mn) * C); m_reg = mn; }
  float mnC = -mn * C;
  for (int r = 0; r < 16; ++r) p0[r] = fmaf(p0[r], C, mnC); for (int r = 0; r < 16; ++r) p1[r] = fmaf(p1[r], C, mnC);
  for (int r = 0; r < 16; ++r) p0[r] = __builtin_amdgcn_exp2f(p0[r]);
}
__device__ __forceinline__ void finishSM(f32x16& p0, f32x16& p1, float alpha, float& l_reg, bf16x8& pa0, bf16x8& pa1, bf16x8& pa2, bf16x8& pa3) {
  for (int r = 0; r < 16; ++r) p1[r] = __builtin_amdgcn_exp2f(p1[r]);
  float ps = 0; for (int r = 0; r < 16; ++r) ps += p0[r]; for (int r = 0; r < 16; ++r) ps += p1[r];
  { auto rr = __builtin_amdgcn_permlane32_swap(__float_as_uint(ps), __float_as_uint(ps), false, false);
    ps = __uint_as_float(rr[0]) + __uint_as_float(rr[1]); }
  l_reg = l_reg * alpha + ps;
#define PK4(P, BASE, OUT) do { unsigned a0 = cvtpk(P[BASE + 0], P[BASE + 1]), a1 = cvtpk(P[BASE + 2], P[BASE + 3]);   \
    unsigned b0 = cvtpk(P[BASE + 4], P[BASE + 5]), b1 = cvtpk(P[BASE + 6], P[BASE + 7]);                              \
    auto r0 = __builtin_amdgcn_permlane32_swap(a0, b0, false, false); auto r1 = __builtin_amdgcn_permlane32_swap(a1, b1, false, false); \
    u32x4 w = {r0[0], r1[0], r0[1], r1[1]}; OUT = *reinterpret_cast<bf16x8*>(&w); } while (0)
  PK4(p0, 0, pa0); PK4(p0, 8, pa1); PK4(p1, 0, pa2); PK4(p1, 8, pa3);
#undef PK4
}
__device__ __forceinline__ void qkt(f32x16& p0, f32x16& p1, const bf16* Ks, const bf16x8* qr, int r32, int hi) {
  p0 = f32x16{}; p1 = f32x16{};
  for (int d0 = 0; d0 < 8; ++d0) { int cb = (d0 * 16 + hi * 8) * 2;
    bf16x8 b0 = *reinterpret_cast<const bf16x8*>((const char*)Ks + KSWZ(r32, cb));
    bf16x8 b1 = *reinterpret_cast<const bf16x8*>((const char*)Ks + KSWZ(32 + r32, cb));
    p0 = __builtin_amdgcn_mfma_f32_32x32x16_bf16(b0, qr[d0], p0, 0, 0, 0);
    p1 = __builtin_amdgcn_mfma_f32_32x32x16_bf16(b1, qr[d0], p1, 0, 0, 0); }
}
__device__ __forceinline__ int v_st(int k, int c) { const int kk = (k & ~0xC) | ((k & 4) << 1) | ((k & 8) >> 1); return ((kk >> 3) * 4 + (c >> 5)) * 512 + ((kk & 7) * 32 + (c & 31)) * 2; }
__device__ __forceinline__ int v_rd_base(int lane) { return ((lane & 3) << 3) | (((lane >> 2) & 3) << 6) | (((lane >> 4) & 1) << 5) | (((lane >> 5) & 1) << 8); }
constexpr int v_rd_off(int d0, int ks, int half) { return d0 * 512 + ks * 4096 + half * 2048; }
template <int OFF> __device__ __forceinline__ s16x4 tr_read(int vb) {
  s16x4 r; asm volatile("ds_read_b64_tr_b16 %0, %1 offset:%2" : "=&v"(r) : "v"(vb), "i"(OFF) : "memory"); return r;
}
template <int D0> __device__ __forceinline__ void pv_one(f32x16& od, int vb, bf16x8 pa0, bf16x8 pa1, bf16x8 pa2, bf16x8 pa3) {
  const s16x4 l0 = tr_read<v_rd_off(D0, 0, 0)>(vb), h0 = tr_read<v_rd_off(D0, 0, 1)>(vb), l1 = tr_read<v_rd_off(D0, 1, 0)>(vb), h1 = tr_read<v_rd_off(D0, 1, 1)>(vb);
  const s16x4 l2 = tr_read<v_rd_off(D0, 2, 0)>(vb), h2 = tr_read<v_rd_off(D0, 2, 1)>(vb), l3 = tr_read<v_rd_off(D0, 3, 0)>(vb), h3 = tr_read<v_rd_off(D0, 3, 1)>(vb);
  asm volatile("s_waitcnt lgkmcnt(0)" ::: "memory"); SBAR();
#define PK(L, H) (bf16x8){L[0], L[1], L[2], L[3], H[0], H[1], H[2], H[3]}
  od = __builtin_amdgcn_mfma_f32_32x32x16_bf16(pa0, PK(l0, h0), od, 0, 0, 0);
  od = __builtin_amdgcn_mfma_f32_32x32x16_bf16(pa1, PK(l1, h1), od, 0, 0, 0);
  od = __builtin_amdgcn_mfma_f32_32x32x16_bf16(pa2, PK(l2, h2), od, 0, 0, 0);
  od = __builtin_amdgcn_mfma_f32_32x32x16_bf16(pa3, PK(l3, h3), od, 0, 0, 0);
#undef PK
}
__device__ __forceinline__ void pv_d0(f32x16* o, int vb, bf16x8 pa0, bf16x8 pa1, bf16x8 pa2, bf16x8 pa3) {
  pv_one<0>(o[0], vb, pa0, pa1, pa2, pa3); pv_one<1>(o[1], vb, pa0, pa1, pa2, pa3); pv_one<2>(o[2], vb, pa0, pa1, pa2, pa3); pv_one<3>(o[3], vb, pa0, pa1, pa2, pa3);
}

template <typename TQ>
__device__ __forceinline__ void attn_dense_body(const TQ* __restrict__ Qb, const bf16* __restrict__ Kh, const bf16* __restrict__ Vh,
                                                bf16* __restrict__ Ob, int seq, char* lds) {
  using St = Stage<bf16>; using SQ = Stage<TQ>;
  int tid = threadIdx.x; asm volatile("" : "+v"(tid));
  const int wid = tid >> 6, lane = tid & 63, r32 = lane & 31, hi = lane >> 5;
  bf16* V_lds = (bf16*)lds; bf16* K_lds = (bf16*)(lds + 2 * SHM_V);
  float* ws = (float*)(lds + 2 * SHM_V + 2 * SHM_K) + wid * 64; float* li_l = ws; float* al_l = ws + 32;
  float m_reg = -1e30f, l_reg = 0; f32x16 o[4] = {}; bf16x8 qr[8];
  const TQ* Qw = Qb + (long)(wid * QBLK + r32) * LDQ + hi * 8;
#pragma unroll
  for (int d0 = 0; d0 < 8; ++d0) qr[d0] = SQ::tobf(SQ::ld8(Qw + d0 * 16));
  const int sr = tid >> 4, sc = (tid & 15) * 8, vst0 = v_st(sr, sc), vst1 = v_st(32 + sr, sc);
  const int vb0 = (int)(uintptr_t)V_lds + v_rd_base(lane);
  struct { typename St::T vs0, vs1, ks0, ks1; } sr_[SDEPTH];
#define SLOAD(i, k0) do { sr_[i].vs0 = St::ld8(&Vh[(long)((k0) + sr) * LDK + sc]); sr_[i].vs1 = St::ld8(&Vh[(long)((k0) + 32 + sr) * LDK + sc]); \
    sr_[i].ks0 = St::ld8(&Kh[(long)((k0) + sr) * LDK + sc]); sr_[i].ks1 = St::ld8(&Kh[(long)((k0) + 32 + sr) * LDK + sc]); } while (0)
#define SWRITE(b, i) do { *(bf16x8*)((char*)V_lds + (b) * SHM_V + vst0) = St::tobf(sr_[i].vs0);          \
    *(bf16x8*)((char*)V_lds + (b) * SHM_V + vst1) = St::tobf(sr_[i].vs1); int kc = sc * 2;               \
    *(bf16x8*)((char*)K_lds + (b) * SHM_K + KSWZ(sr, kc)) = St::tobf(sr_[i].ks0);                       \
    *(bf16x8*)((char*)K_lds + (b) * SHM_K + KSWZ(32 + sr, kc)) = St::tobf(sr_[i].ks1); } while (0)
#define SWAIT() do { if constexpr (SDEPTH == 2) asm volatile("s_waitcnt vmcnt(4)" ::: "memory"); else asm volatile("s_waitcnt vmcnt(0)" ::: "memory"); } while (0)
#define RESC(a) do { if (__any((a) < 1.f)) { if (hi == 0) al_l[r32] = (a); asm volatile("s_waitcnt lgkmcnt(0)" ::: "memory"); \
    for (int d = 0; d < 4; ++d) for (int r = 0; r < 16; ++r) o[d][r] *= al_l[crow(r, hi)]; } } while (0)
  f32x16 pA0, pA1, pB0, pB1; float mnA, mnB, alA, alB; bf16x8 pa0, pa1, pa2, pa3; const int NT = seq / KVBLK;
  constexpr int SE = 0, SO = SDEPTH - 1;
  SLOAD(SE, 0); asm volatile("s_waitcnt vmcnt(0)" ::: "memory"); SWRITE(0, SE); __syncthreads();
  qkt(pA0, pA1, K_lds, qr, r32, hi); partialSM(pA0, pA1, m_reg, mnA, alA);
  SLOAD(SO, KVBLK); if constexpr (SDEPTH == 2) { if (2 < NT) SLOAD(SE, 2 * KVBLK); }
  SWAIT(); SWRITE(1, SO); __syncthreads();
  for (int j = 1; j + 1 < NT; j += 2) {
    SBAR(); qkt(pB0, pB1, (bf16*)((char*)K_lds + SHM_K), qr, r32, hi);
    finishSM(pA0, pA1, alA, l_reg, pa0, pa1, pa2, pa3); SBAR();
    SLOAD(SO, (j + SDEPTH) * KVBLK); SBAR();
    pv_d0(o, vb0, pa0, pa1, pa2, pa3); partialSM(pB0, pB1, m_reg, mnB, alB);
    __syncthreads(); SWAIT(); SWRITE(0, SE);
    RESC(alB); __syncthreads();
    SBAR(); qkt(pA0, pA1, K_lds, qr, r32, hi);
    finishSM(pB0, pB1, alB, l_reg, pa0, pa1, pa2, pa3); SBAR();
    if (SDEPTH == 1 || j + 3 < NT) SLOAD(SE, (j + 1 + SDEPTH) * KVBLK); SBAR();
    pv_d0(o, vb0 + (int)SHM_V, pa0, pa1, pa2, pa3); partialSM(pA0, pA1, m_reg, mnA, alA);
    __syncthreads(); SWAIT(); SWRITE(1, SO);
    RESC(alA); __syncthreads();
  }
  SBAR(); qkt(pB0, pB1, (bf16*)((char*)K_lds + SHM_K), qr, r32, hi);
  finishSM(pA0, pA1, alA, l_reg, pa0, pa1, pa2, pa3); SBAR();
  pv_d0(o, vb0, pa0, pa1, pa2, pa3); partialSM(pB0, pB1, m_reg, mnB, alB);
  __syncthreads(); RESC(alB);
  finishSM(pB0, pB1, alB, l_reg, pa0, pa1, pa2, pa3); SBAR();
  pv_d0(o, vb0 + (int)SHM_V, pa0, pa1, pa2, pa3);
  if (hi == 0) li_l[r32] = l_reg; asm volatile("s_waitcnt lgkmcnt(0)" ::: "memory");
  float rli[16];
#pragma unroll
  for (int r = 0; r < 16; ++r) rli[r] = __builtin_amdgcn_rcpf(li_l[crow(r, hi)]);
  bf16* Ow = Ob + (long)(wid * QBLK) * LDO;
#pragma unroll
  for (int r = 0; r < 16; ++r) { int orow = crow(r, hi);
    for (int d0 = 0; d0 < 4; ++d0) Ow[(long)orow * LDO + d0 * 32 + r32] = (bf16)(cvtpk(o[d0][r] * rli[r], 0.f) & 0xffffu); }
#undef SLOAD
#undef SWRITE
#undef SWAIT
#undef RESC
}


#undef KSWZ
#undef SBAR
}

#define GAS __attribute__((address_space(1)))
#define LAS __attribute__((address_space(3)))
typedef unsigned v4u __attribute__((ext_vector_type(4)));
typedef float f32x4 __attribute__((ext_vector_type(4)));
typedef short bf16x8 __attribute__((ext_vector_type(8)));
typedef GAS unsigned gu32;
typedef GAS unsigned long long gu64;
#define RLX_AGENT __ATOMIC_RELAXED, __HIP_MEMORY_SCOPE_AGENT
#define LDS_WAIT() asm volatile("s_waitcnt lgkmcnt(0)" ::: "memory")
#define VM_WAIT() asm volatile("s_waitcnt vmcnt(0)" ::: "memory")
__device__ __forceinline__ unsigned long long rt() { return __builtin_amdgcn_s_memrealtime(); }
__device__ __forceinline__ unsigned f2bf(float f) { unsigned u = __builtin_bit_cast(unsigned, f); return (u + 0x7fffu + ((u >> 16) & 1u)) >> 16; }
__device__ __forceinline__ unsigned pk2(float lo, float hi) { return f2bf(lo) | (f2bf(hi) << 16); }

#define XB_TMO      128
#define XB_XCNT(j)  (256  + 64 * (j))
#define XB_XSUB(j)  (1280 + 64 * (j))
#define XB_XGEN(j)  (2304 + 64 * (j))
#define XB_TOP      3328
#define XB_TOPGEN   3392
#define XCD_BAR_WORDS 3456
#define XB_SPIN_CAP (1u << 18)

__device__ __forceinline__ unsigned xb_ld(unsigned* p)              { return __hip_atomic_load(p, __ATOMIC_RELAXED, __HIP_MEMORY_SCOPE_AGENT); }
__device__ __forceinline__ unsigned xb_add(unsigned* p, unsigned v) { return __hip_atomic_fetch_add(p, v, __ATOMIC_RELAXED, __HIP_MEMORY_SCOPE_AGENT); }
__device__ __forceinline__ unsigned xb_xcc_id() { return (unsigned)__builtin_amdgcn_s_getreg((3 << 11) | 20) & 0xFu; }
#define XB_SPIN(cond, bar) do { unsigned _sp = 0; while (cond) { __builtin_amdgcn_s_sleep(1); \
    if ((++_sp & 255u) == 0u) { if (xb_ld(&(bar)[XB_TMO])) break; if (_sp > XB_SPIN_CAP) { atomicAdd(&(bar)[XB_TMO], 1u); break; } } } } while (0)

struct XcdBarrier {
    unsigned* bar; unsigned x;
    volatile LAS unsigned* st;
};

__device__ __forceinline__ XcdBarrier xcd_barrier_post(unsigned* bar, volatile LAS unsigned* st) {
    XcdBarrier b; b.bar = bar; b.x = xb_xcc_id(); b.st = st;
    if (threadIdx.x == 0) (void)xb_add(&bar[XB_XCNT(b.x)], 1u);
    return b;
}
__device__ __forceinline__ void xcd_barrier_complete(unsigned* bar, unsigned x, unsigned& nloc, unsigned& nx) {
    const unsigned G = gridDim.x * gridDim.y * gridDim.z;
    unsigned sum, cnt, mine, sp = 0u;
    for (;;) {
        sum = 0u; cnt = 0u; mine = 0u;
#pragma unroll
        for (unsigned j = 0; j < 16; ++j) { const unsigned c = xb_ld(&bar[XB_XCNT(j)]); sum += c; cnt += (c > 0u) ? 1u : 0u; mine = (j == x) ? c : mine; }
        if (sum == G) break;
        __builtin_amdgcn_s_sleep(1);
        if ((++sp & 255u) == 0u) { if (xb_ld(&bar[XB_TMO])) break; if (sp > XB_SPIN_CAP) { atomicAdd(&bar[XB_TMO], 1u); break; } }
    }
    nloc = mine > 0u ? mine : 1u; nx = cnt > 0u ? cnt : 1u;
}

__device__ __forceinline__ void xcd_barrier(const XcdBarrier& b) {
    asm volatile("s_waitcnt vmcnt(0)" ::: "memory");
    __syncthreads();
    if (threadIdx.x == 0) {
        unsigned* bar = b.bar;
        __builtin_amdgcn_s_waitcnt(0);
        unsigned nloc = b.st[0], nx = b.st[1];
        if (nloc == 0u) { xcd_barrier_complete(bar, b.x, nloc, nx); b.st[0] = nloc; b.st[1] = nx; }
        const unsigned old = xb_add(&bar[XB_XSUB(b.x)], 1u);
        const unsigned gen = old / nloc;
        if (old + 1u == (gen + 1u) * nloc) {
            __builtin_amdgcn_fence(__ATOMIC_RELEASE, "agent");
            asm volatile("s_waitcnt vmcnt(0)" ::: "memory");
            const unsigned og = xb_add(&bar[XB_TOP], 1u);
            const unsigned tg = og / nx;
            if (og + 1u == (tg + 1u) * nx) xb_add(&bar[XB_TOPGEN], 1u);
            else XB_SPIN(xb_ld(&bar[XB_TOPGEN]) == tg, bar);
            __builtin_amdgcn_fence(__ATOMIC_ACQUIRE, "agent");
            xb_add(&bar[XB_XGEN(b.x)], 1u);
            asm volatile("s_waitcnt vmcnt(0)" ::: "memory");
        } else {
            XB_SPIN(xb_ld(&bar[XB_XGEN(b.x)]) == gen, bar);
            __builtin_amdgcn_fence(__ATOMIC_ACQUIRE, "agent");
            asm volatile("s_waitcnt vmcnt(0)" ::: "memory");
        }
    }
    __syncthreads();
}

typedef unsigned short bf16;
typedef float f32x2 __attribute__((ext_vector_type(2)));
typedef float f32x16 __attribute__((ext_vector_type(16)));
typedef __bf16 bf16x2_t __attribute__((ext_vector_type(2)));
constexpr int NWAVES = 8, NTHR = 512;
constexpr int LDS_BYTES = 147456, LDSCTL_OFF = LDS_BYTES - 256;
constexpr int CW_BAR = 1024;
static_assert((CW_BAR + XCD_BAR_WORDS) * 4 <= (int)CTL_ZERO_BYTES, "control words inside the memset region");

struct Args {
    const float *x, *c, *ada_w, *ada_b, *norm_mix_w, *w_in, *q_norm_w, *k_norm_w, *w_attn_o, *pool_mix_w, *pool_scale, *w_pool_o, *w_out, *norm_ffn_w,
                *w_query, *sub_keys, *expert_u, *expert_v, *final_norm_w;
    float* out; unsigned char* ws; int ph_lo, ph_hi;
};

__device__ __forceinline__ unsigned pkbf(float lo, float hi) { return pg8::cvt_pk_bf16(lo, hi); }
__device__ __forceinline__ float bflo(unsigned w) { return __builtin_bit_cast(float, w << 16); }
__device__ __forceinline__ float bfhi(unsigned w) { return __builtin_bit_cast(float, w & 0xffff0000u); }
__device__ __forceinline__ float wave_sum(float v) {
#pragma unroll
    for (int o = 1; o < 64; o <<= 1) v += __shfl_xor(v, o);
    return v;
}
__device__ __forceinline__ float dot2bf(unsigned a, unsigned b, float acc) { return __builtin_amdgcn_fdot2_f32_bf16(__builtin_bit_cast(bf16x2_t, a), __builtin_bit_cast(bf16x2_t, b), acc, false); }

__device__ __forceinline__ void p0_transpose_item(const float* W, int K, int N, bf16* WT, LAS float* scr, int item, int lane) {
    const int nblk = N / 32, kb = item / nblk, nb = item % nblk, k0 = 64 * kb, n0 = 32 * nb;
#pragma unroll 8
    for (int i = 0; i < 32; ++i) { const int kk = 2 * i + (lane >> 5); scr[kk * 33 + (lane & 31)] = W[(size_t)(k0 + kk) * N + n0 + (lane & 31)]; }
    LDS_WAIT(); asm volatile("" ::: "memory");
    const int c = lane & 7;
#pragma unroll
    for (int j = 0; j < 4; ++j) { const int n = (lane >> 3) + 8 * j; const LAS float* s = scr + (8 * c) * 33 + n;
        v4u o; o.x = pkbf(s[0 * 33], s[1 * 33]); o.y = pkbf(s[2 * 33], s[3 * 33]); o.z = pkbf(s[4 * 33], s[5 * 33]); o.w = pkbf(s[6 * 33], s[7 * 33]);
        *(v4u*)(WT + (size_t)(n0 + n) * K + k0 + 8 * c) = o; }
    LDS_WAIT(); asm volatile("" ::: "memory");
}
__device__ __forceinline__ void cvt8_range(const float* src, bf16* dst, size_t n8, int gt, int NGT) {
    for (size_t i = gt; i < n8; i += NGT) {
        const f32x4 a = *(const f32x4*)(src + i * 8), b = *(const f32x4*)(src + i * 8 + 4);
        v4u o; o.x = pkbf(a[0], a[1]); o.y = pkbf(a[2], a[3]); o.z = pkbf(b[0], b[1]); o.w = pkbf(b[2], b[3]);
        *(v4u*)(dst + i * 8) = o;
    }
}
__device__ __forceinline__ void p0_prologue(const Args& a, LAS unsigned char* lds, int tid, int lane, int wave, int bid, int G) {
    unsigned char* ws = a.ws;
    const int gw = bid * NWAVES + wave, NGW = G * NWAVES, gt = bid * NTHR + tid, NGT = G * NTHR;
    {
        LAS float* cs = (LAS float*)lds;
        LAS float* red = (LAS float*)(lds + 16384);
        float* MOD = (float*)(ws + WS_MOD);
        if (bid < 192 || G < 192) {
            for (int k = tid; k < 1024; k += NTHR)
#pragma unroll
                for (int b = 0; b < 4; ++b) { const float v = a.c[b * 1024 + k]; cs[k * 4 + b] = v / (1.f + __expf(-v)); }
            __syncthreads();
            for (int bt = bid; bt < 192; bt += G) {
                const int l = bt / 96, n0 = (bt % 96) * 64;
                const float* wp = a.ada_w + ((size_t)l * 1024 + wave * 128) * 6144 + n0 + lane;
                float acc0 = 0.f, acc1 = 0.f, acc2 = 0.f, acc3 = 0.f;
#pragma unroll 16
                for (int kk = 0; kk < 128; ++kk) {
                    const float wv = wp[(size_t)kk * 6144];
                    const f32x4 c4 = *(const LAS f32x4*)(cs + (wave * 128 + kk) * 4);
                    acc0 += c4[0] * wv; acc1 += c4[1] * wv; acc2 += c4[2] * wv; acc3 += c4[3] * wv;
                }
                red[(wave * 4 + 0) * 64 + lane] = acc0; red[(wave * 4 + 1) * 64 + lane] = acc1; red[(wave * 4 + 2) * 64 + lane] = acc2; red[(wave * 4 + 3) * 64 + lane] = acc3;
                __syncthreads();
                if (tid < 256) { const int b = tid >> 6; float s = a.ada_b[l * 6144 + n0 + lane];
#pragma unroll
                    for (int w = 0; w < 8; ++w) s += red[(w * 4 + b) * 64 + lane];
                    MOD[(size_t)(l * 4 + b) * 6144 + n0 + lane] = s; }
                __syncthreads();
            }
        }
        __syncthreads();
    }
    {
        f32x2* RT = (f32x2*)(ws + WS_ROPE);
        for (int idx = gt; idx < 192 * 32; idx += NGT) {
            const int pos = idx >> 5, i = idx & 31; const float pv = (float)(pos < 128 ? pos : pos - 128);
            const float inv = exp2f(-(float)i * (13.287712379549449f / 32.f));
            const float ang = pv * inv;
            f32x2 cs2; cs2.x = __cosf(ang); cs2.y = __sinf(ang); RT[idx] = cs2;
        }
    }
    {
        LAS float* scr = (LAS float*)(lds + wave * 16384);
        constexpr int I_IN = 16 * 128, I_AO = 16 * 32, I_PO = 8 * 32, I_OUT = 16 * 32, I_Q = 16 * 128, I_L = I_IN + I_AO + I_PO + I_OUT + I_Q;
        for (int it = gw; it < 2 * I_L; it += NGW) {
            const int l = it / I_L; int r = it % I_L;
            if (r < I_IN) { p0_transpose_item(a.w_in + (size_t)l * 1024 * 4096, 1024, 4096, (bf16*)(ws + WS_WIN) + (size_t)l * 4096 * 1024, scr, r, lane); continue; } r -= I_IN;
            if (r < I_AO) { p0_transpose_item(a.w_attn_o + (size_t)l * 1024 * 1024, 1024, 1024, (bf16*)(ws + WS_WAO) + (size_t)l * 1024 * 1024, scr, r, lane); continue; } r -= I_AO;
            if (r < I_PO) { p0_transpose_item(a.w_pool_o + (size_t)l * 512 * 1024, 512, 1024, (bf16*)(ws + WS_WPO) + (size_t)l * 1024 * 512, scr, r, lane); continue; } r -= I_PO;
            if (r < I_OUT) { p0_transpose_item(a.w_out + (size_t)l * 1024 * 1024, 1024, 1024, (bf16*)(ws + WS_WOUT) + (size_t)l * 1024 * 1024, scr, r, lane); continue; } r -= I_OUT;
            p0_transpose_item(a.w_query + (size_t)l * 1024 * 4096, 1024, 4096, (bf16*)(ws + WS_WQ) + (size_t)l * 4096 * 1024, scr, r, lane);
        }
    }
    {
        bf16* WM = (bf16*)(ws + WS_WMIX);
        for (int i = gt; i < 2 * 512 * 64; i += NGT) {
            const int l = i / (512 * 64), r = i % (512 * 64), n = r >> 6, k0 = (r & 63) * 8, g = n >> 7, d = n & 127;
            v4u o = {0u, 0u, 0u, 0u};
            if ((k0 >> 7) == g) { const float* p = a.pool_mix_w + (((size_t)(l * 4 + g) * 128 + (k0 & 127)) * 128 + d);
                o.x = pkbf(p[0], p[128]); o.y = pkbf(p[256], p[384]); o.z = pkbf(p[512], p[640]); o.w = pkbf(p[768], p[896]); }
            *(v4u*)(WM + ((size_t)l * 512 + n) * 512 + k0) = o;
        }
    }
    cvt8_range(a.sub_keys, (bf16*)(ws + WS_SUBK), (size_t)2 * 8 * 2 * 128 * 256 / 8, gt, NGT);
    cvt8_range(a.expert_u, (bf16*)(ws + WS_EXPU), (size_t)NEXP * 1024 / 8, gt, NGT);
    cvt8_range(a.expert_v, (bf16*)(ws + WS_EXPV), (size_t)NEXP * 1024 / 8, gt, NGT);
}

__device__ __forceinline__ void normmod_phase(const float* X, const float* w, const float* modl, int sh_off, int sc_off, bf16* XN, int gw, int NGW, int lane) {
    const int per = (TOK + NGW - 1) / NGW, r0 = gw * per, r1 = (r0 + per < TOK) ? r0 + per : TOK;
    int curb = -1; f32x4 A[4], Bv[4];
    for (int r = r0; r < r1; ++r) {
        const int b = r >> 13;
        if (b != curb) { curb = b;
#pragma unroll
            for (int j = 0; j < 4; ++j) { const f32x4 wv = *(const f32x4*)(w + 4 * lane + 256 * j); const f32x4 sc = *(const f32x4*)(modl + (size_t)b * 6144 + sc_off + 4 * lane + 256 * j);
                A[j] = wv * (sc + 1.0f); Bv[j] = *(const f32x4*)(modl + (size_t)b * 6144 + sh_off + 4 * lane + 256 * j); } }
        f32x4 v[4]; float ss = 0.f;
#pragma unroll
        for (int j = 0; j < 4; ++j) { v[j] = *(const f32x4*)(X + (size_t)r * 1024 + 4 * lane + 256 * j); ss += (v[j][0] * v[j][0] + v[j][1] * v[j][1]) + (v[j][2] * v[j][2] + v[j][3] * v[j][3]); }
        const float rstd = rsqrtf(wave_sum(ss) * (1.f / 1024.f) + EPS);
#pragma unroll
        for (int j = 0; j < 4; ++j) { const f32x4 y = v[j] * rstd * A[j] + Bv[j];
            f32x2 o; ((unsigned*)&o)[0] = pkbf(y[0], y[1]); ((unsigned*)&o)[1] = pkbf(y[2], y[3]);
            *(f32x2*)(XN + (size_t)r * 1024 + 4 * lane + 256 * j) = o; }
    }
}

__device__ __forceinline__ void qknorm_rope_phase(bf16* Q, bf16* K, const float* qw, const float* kw, const f32x2* RT, int gw, int NGW, int lane) {
    const int sub = lane & 15, grp = lane >> 4;
    for (int i = gw; i < TOK * 10 / 4; i += NGW) {
        const int it = i * 4 + grp, t = it / 10, hd = it % 10;
        bf16* p = (hd < 8) ? (Q + (size_t)t * 1024 + hd * 128 + sub * 8) : (K + (size_t)t * 256 + (hd - 8) * 128 + sub * 8);
        const float* wn = ((hd < 8) ? qw : kw) + sub * 8;
        const v4u raw = *(const v4u*)p;
        float x[8] = {bflo(raw.x), bfhi(raw.x), bflo(raw.y), bfhi(raw.y), bflo(raw.z), bfhi(raw.z), bflo(raw.w), bfhi(raw.w)};
        float ss = 0.f;
#pragma unroll
        for (int e = 0; e < 8; ++e) ss += x[e] * x[e];
        ss += __shfl_xor(ss, 1); ss += __shfl_xor(ss, 2); ss += __shfl_xor(ss, 4); ss += __shfl_xor(ss, 8);
        const float rstd = rsqrtf(ss * (1.f / 128.f) + EPS);
        const f32x4 w0 = *(const f32x4*)wn, w1 = *(const f32x4*)(wn + 4);
        float y[8];
#pragma unroll
        for (int e = 0; e < 8; ++e) y[e] = x[e] * rstd * (e < 4 ? w0[e] : w1[e - 4]);
        const int tl = t & (SEQ - 1), pos = (sub & 8) ? (128 + (tl & 63)) : (tl >> 6);
        const f32x2* rt = RT + pos * 32 + (sub & 3) * 8;
        const float sgn = (sub & 4) ? 1.f : -1.f;
        float o[8];
#pragma unroll
        for (int e = 0; e < 8; ++e) { const float pr = __shfl_xor(y[e], 4); const f32x2 cs2 = rt[e]; o[e] = y[e] * cs2.x + sgn * pr * cs2.y; }
        v4u ov; ov.x = pkbf(o[0], o[1]); ov.y = pkbf(o[2], o[3]); ov.z = pkbf(o[4], o[5]); ov.w = pkbf(o[6], o[7]);
        *(v4u*)p = ov;
    }
}
__device__ __forceinline__ void poolwin_phase(const bf16* UP, bf16* Mo, int gt, int NGT) {
    for (int i = gt; i < TOK * 64; i += NGT) {
        const int t = i >> 6, ch = i & 63, g = ch >> 4, half = 1 << g, tl = t & (SEQ - 1);
        const int lo = (tl - half > 0) ? tl - half : 0, hi = (tl + half < SEQ) ? tl + half : SEQ;
        const bf16* base = UP + (size_t)(t - tl) * 512 + ch * 8;
        float s[8] = {0.f, 0.f, 0.f, 0.f, 0.f, 0.f, 0.f, 0.f};
        for (int r = lo; r < hi; ++r) { const v4u v = *(const v4u*)(base + (size_t)r * 512);
            s[0] += bflo(v.x); s[1] += bfhi(v.x); s[2] += bflo(v.y); s[3] += bfhi(v.y); s[4] += bflo(v.z); s[5] += bfhi(v.z); s[6] += bflo(v.w); s[7] += bfhi(v.w); }
        const v4u c = *(const v4u*)(base + (size_t)tl * 512);
        const float ic = 1.f / (float)(hi - lo);
        v4u o; o.x = pkbf(s[0] * ic - bflo(c.x), s[1] * ic - bfhi(c.x)); o.y = pkbf(s[2] * ic - bflo(c.y), s[3] * ic - bfhi(c.y));
        o.z = pkbf(s[4] * ic - bflo(c.z), s[5] * ic - bfhi(c.z)); o.w = pkbf(s[6] * ic - bflo(c.w), s[7] * ic - bfhi(c.w));
        *(v4u*)(Mo + (size_t)t * 512 + ch * 8) = o;
    }
}

__device__ __forceinline__ unsigned f2ord(float f) { const unsigned u = __builtin_bit_cast(unsigned, f); return (u & 0x80000000u) ? ~u : (u | 0x80000000u); }
__device__ __forceinline__ float ord2f(unsigned o) { const unsigned u = (o & 0x80000000u) ? (o & 0x7fffffffu) : ~o; return __builtin_bit_cast(float, u); }
#define TK_INSERT(L, xin) do { unsigned _x = (xin); _Pragma("unroll") for (int _i = 0; _i < 16; ++_i) { const unsigned _t = L[_i] > _x ? L[_i] : _x; _x = L[_i] > _x ? _x : L[_i]; L[_i] = _t; } } while (0)
#define TK_MERGE32(L) do { unsigned _P[16]; _Pragma("unroll") for (int _i = 0; _i < 16; ++_i) _P[_i] = (unsigned)__shfl_xor((int)L[_i], 32); \
    _Pragma("unroll") for (int _i = 0; _i < 16; ++_i) L[_i] = L[_i] > _P[15 - _i] ? L[_i] : _P[15 - _i]; \
    _Pragma("unroll") for (int _k = 8; _k >= 1; _k >>= 1) { _Pragma("unroll") for (int _i = 0; _i < 16; ++_i) if ((_i & _k) == 0) { const unsigned _a = L[_i], _b = L[_i + _k]; L[_i] = _a > _b ? _a : _b; L[_i + _k] = _a > _b ? _b : _a; } } } while (0)

__device__ __forceinline__ void topk_phase(const bf16* QP, const bf16* SUBKl, int* EIDX, float* GS, LAS unsigned char* lds, int tid, int lane, int wave, int bid, int G) {
    const int h = bid & 7, slot = (bid >> 3) * NWAVES + wave, nslot = (((G - 1 - h) >> 3) + 1) * NWAVES;
    const int r32 = lane & 31, hi = lane >> 5;
    constexpr int KROW = 528;
    {   const v4u* src = (const v4u*)(SUBKl + (size_t)h * (2 * 128 * 256));
        for (int ci = tid; ci < 2 * 128 * 32; ci += NTHR) { const int row = ci >> 5, ch = ci & 31; *(LAS v4u*)(lds + row * KROW + ch * 16) = src[ci]; }
    }
    __syncthreads();
    for (int tile = slot; tile < TOK / 32; tile += nslot) {
        const int tok = tile * 32 + r32;
        const bf16* qrow = QP + (size_t)tok * 4096 + h * 512 + hi * 8;
        unsigned LA[16], LB[16];
#pragma unroll
        for (int p = 0; p < 2; ++p) {
            bf16x8 bq[16];
#pragma unroll
            for (int ks = 0; ks < 16; ++ks) bq[ks] = *(const bf16x8*)(qrow + p * 256 + ks * 16);
            unsigned L[16];
#pragma unroll
            for (int i = 0; i < 16; ++i) L[i] = 0u;
#pragma unroll 1
            for (int kt = 0; kt < 4; ++kt) {
                f32x16 acc = f32x16{};
                const LAS unsigned char* kb = lds + (p * 128 + kt * 32 + r32) * KROW + hi * 16;
#pragma unroll
                for (int ks = 0; ks < 16; ++ks) { const bf16x8 af = *(const LAS bf16x8*)(kb + ks * 32); acc = __builtin_amdgcn_mfma_f32_32x32x16_bf16(af, bq[ks], acc, 0, 0, 0); }
#pragma unroll
                for (int r = 0; r < 16; ++r) { const int n = kt * 32 + (r & 3) + 8 * (r >> 2) + 4 * hi; const unsigned key = (f2ord(acc[r]) & 0xFFFFFF80u) | (unsigned)(127 - n); TK_INSERT(L, key); }
            }
            TK_MERGE32(L);
#pragma unroll
            for (int i = 0; i < 16; ++i) { if (p == 0) LA[i] = L[i]; else LB[i] = L[i]; }
        }
        float va[16], vb[16];
#pragma unroll
        for (int i = 0; i < 16; ++i) { va[i] = ord2f(LA[i] & 0xFFFFFF80u); vb[i] = ord2f(LB[i] & 0xFFFFFF80u); }
        unsigned ta[4] = {0u, 0u, 0u, 0u}, tb[4] = {0u, 0u, 0u, 0u};
#pragma unroll
        for (int i = 0; i < 16; ++i) { ta[i >> 2] |= (127u - (LA[i] & 127u)) << ((i & 3) * 8); tb[i >> 2] |= (127u - (LB[i] & 127u)) << ((i & 3) * 8); }
        unsigned C[16];
#pragma unroll
        for (int i = 0; i < 16; ++i) C[i] = 0u;
#pragma unroll
        for (int i = 0; i < 16; ++i)
#pragma unroll
            for (int j = 0; j < 16 / (i + 1); ++j) { const unsigned key = (f2ord(va[i] + vb[j]) & 0xFFFFFF00u) | (unsigned)(255 - (i * 16 + j)); TK_INSERT(C, key); }
        const float smax = ord2f(C[0] & 0xFFFFFF00u);
        float ev[16]; float esum = 0.f; int ei[16];
#pragma unroll
        for (int k = 0; k < 16; ++k) {
            const unsigned cid = 255u - (C[k] & 255u), ci = cid >> 4, cj = cid & 15u;
            const unsigned wa = (ci & 8u) ? ((ci & 4u) ? ta[3] : ta[2]) : ((ci & 4u) ? ta[1] : ta[0]);
            const unsigned wb = (cj & 8u) ? ((cj & 4u) ? tb[3] : tb[2]) : ((cj & 4u) ? tb[1] : tb[0]);
            const unsigned ia = (wa >> ((ci & 3u) * 8u)) & 255u, ib = (wb >> ((cj & 3u) * 8u)) & 255u;
            ei[k] = (int)(ia * 128u + ib);
            ev[k] = __expf(ord2f(C[k] & 0xFFFFFF00u) - smax); esum += ev[k];
        }
        const float inv = 1.f / esum;
        if (hi == 0) { int* ep = EIDX + (size_t)tok * 128 + h * 16;
#pragma unroll
            for (int q = 0; q < 4; ++q) { v4u o; o.x = (unsigned)ei[4 * q]; o.y = (unsigned)ei[4 * q + 1]; o.z = (unsigned)ei[4 * q + 2]; o.w = (unsigned)ei[4 * q + 3]; *(v4u*)(ep + 4 * q) = o; }
        } else { float* gp = GS + (size_t)tok * 128 + h * 16;
#pragma unroll
            for (int q = 0; q < 4; ++q) { f32x4 o; o[0] = ev[4 * q] * inv; o[1] = ev[4 * q + 1] * inv; o[2] = ev[4 * q + 2] * inv; o[3] = ev[4 * q + 3] * inv; *(f32x4*)(gp + 4 * q) = o; }
        }
    }
}

template <bool LAST>
__device__ __forceinline__ void gather_phase(const bf16* XF, const int* EIDX, const float* GS, const bf16* EU, const bf16* EV, float* X, const float* g2p  ,
                                             const float* wnext, const float* modn  , bf16* XN, int gw, int NGW, int lane) {
    const int per = (TOK + NGW - 1) / NGW, r0 = gw * per, r1 = (r0 + per < TOK) ? r0 + per : TOK;
    const int b5 = lane & 32, b4 = lane & 16, b3 = lane & 8, l7 = lane & 7;
    const int plane = 8 * l7 + (lane >> 3);
    for (int t = r0; t < r1; ++t) {
        const int b = t >> 13;
        const v4u xa = *(const v4u*)(XF + (size_t)t * 1024 + lane * 8), xb = *(const v4u*)(XF + (size_t)t * 1024 + 512 + lane * 8);
        const int e0 = EIDX[(size_t)t * 128 + lane], e1 = EIDX[(size_t)t * 128 + 64 + lane];
        const float gq0 = GS[(size_t)t * 128 + plane], gq1 = GS[(size_t)t * 128 + 64 + plane];
        float hv0 = 0.f, hv1 = 0.f;
#define ROW_LOAD(T, ra, rb, ev, slot) do { const int _e = __builtin_amdgcn_readlane((ev), (slot)); const v4u* _p = (const v4u*)((T) + (size_t)_e * 1024); (ra) = _p[lane]; (rb) = _p[64 + lane]; } while (0)
#define U_DOT(ra, rb, out) do { float _s0 = dot2bf((ra).x, xa.x, 0.f), _s1 = dot2bf((ra).y, xa.y, 0.f); _s0 = dot2bf((ra).z, xa.z, _s0); _s1 = dot2bf((ra).w, xa.w, _s1); \
            _s0 = dot2bf((rb).x, xb.x, _s0); _s1 = dot2bf((rb).y, xb.y, _s1); _s0 = dot2bf((rb).z, xb.z, _s0); _s1 = dot2bf((rb).w, xb.w, _s1); (out) = _s0 + _s1; } while (0)
#define U_REDUCE(c) do { float _q[4]; _Pragma("unroll") for (int _j = 0; _j < 4; ++_j) { const float _keep = b5 ? pp[_j + 4] : pp[_j], _send = b5 ? pp[_j] : pp[_j + 4]; _q[_j] = _keep + __shfl_xor(_send, 32); } \
            float _r[2]; _Pragma("unroll") for (int _j = 0; _j < 2; ++_j) { const float _keep = b4 ? _q[_j + 2] : _q[_j], _send = b4 ? _q[_j] : _q[_j + 2]; _r[_j] = _keep + __shfl_xor(_send, 16); } \
            float _s = (b3 ? _r[1] : _r[0]) + __shfl_xor(b3 ? _r[0] : _r[1], 8); _s += __shfl_xor(_s, 4); _s += __shfl_xor(_s, 2); _s += __shfl_xor(_s, 1); \
            if (l7 == ((c) & 7)) { if ((c) < 8) hv0 = _s; else hv1 = _s; } } while (0)
        {
            v4u ua[8], ub[8]; float pp[8];
#pragma unroll
            for (int j = 0; j < 8; ++j) ROW_LOAD(EU, ua[j], ub[j], e0, j);
#pragma unroll 1
            for (int c = 0; c < 15; ++c) {
                const int evn = (c + 1 < 8) ? e0 : e1, sn = ((c + 1) & 7) * 8;
#pragma unroll
                for (int j = 0; j < 8; ++j) { U_DOT(ua[j], ub[j], pp[j]); ROW_LOAD(EU, ua[j], ub[j], evn, sn + j); }
                U_REDUCE(c);
            }
#pragma unroll
            for (int j = 0; j < 8; ++j) U_DOT(ua[j], ub[j], pp[j]);
            U_REDUCE(15);
        }
#undef U_DOT
#undef U_REDUCE
        const float act0 = 0.5f * hv0 * (1.f + erff(hv0 * 0.70710678118654752f)) * gq0, act1 = 0.5f * hv1 * (1.f + erff(hv1 * 0.70710678118654752f)) * gq1;
        float o[16];
#pragma unroll
        for (int i = 0; i < 16; ++i) o[i] = 0.f;
#define V_ACC(ra, rb, av, srcl) do { const float _a = __builtin_bit_cast(float, __builtin_amdgcn_readlane(__builtin_bit_cast(int, (av)), (srcl))); \
            o[0] += _a * bflo((ra).x); o[1] += _a * bfhi((ra).x); o[2] += _a * bflo((ra).y); o[3] += _a * bfhi((ra).y); o[4] += _a * bflo((ra).z); o[5] += _a * bfhi((ra).z); o[6] += _a * bflo((ra).w); o[7] += _a * bfhi((ra).w); \
            o[8] += _a * bflo((rb).x); o[9] += _a * bfhi((rb).x); o[10] += _a * bflo((rb).y); o[11] += _a * bfhi((rb).y); o[12] += _a * bflo((rb).z); o[13] += _a * bfhi((rb).z); o[14] += _a * bflo((rb).w); o[15] += _a * bfhi((rb).w); } while (0)
        {
            v4u va[8], vb[8];
#pragma unroll
            for (int j = 0; j < 8; ++j) ROW_LOAD(EV, va[j], vb[j], e0, j);
#pragma unroll 1
            for (int c = 0; c < 15; ++c) {
                const int evn = (c + 1 < 8) ? e0 : e1, sn = ((c + 1) & 7) * 8; const float av = (c < 8) ? act0 : act1;
#pragma unroll
                for (int j = 0; j < 8; ++j) { V_ACC(va[j], vb[j], av, 8 * j + (c & 7)); ROW_LOAD(EV, va[j], vb[j], evn, sn + j); }
            }
#pragma unroll
            for (int j = 0; j < 8; ++j) V_ACC(va[j], vb[j], act1, 8 * j + 7);
        }
#undef V_ACC
#undef ROW_LOAD
        float* xr = X + (size_t)t * 1024; const float* gr = g2p + (size_t)b * 6144;
        float x2[16]; float ss = 0.f;
#pragma unroll
        for (int q = 0; q < 4; ++q) { const int col = (q >> 1) * 512 + lane * 8 + (q & 1) * 4; const f32x4 xi = *(const f32x4*)(xr + col), gg = *(const f32x4*)(gr + col);
#pragma unroll
            for (int e = 0; e < 4; ++e) { const float v = xi[e] + gg[e] * o[q * 4 + e]; x2[q * 4 + e] = v; ss += v * v; } }
        const float rstd = rsqrtf(wave_sum(ss) * (1.f / 1024.f) + EPS);
#pragma unroll
        for (int q = 0; q < 4; ++q) { const int col = (q >> 1) * 512 + lane * 8 + (q & 1) * 4; const f32x4 wv = *(const f32x4*)(wnext + col);
            if (LAST) { f32x4 ov;
#pragma unroll
                for (int e = 0; e < 4; ++e) ov[e] = x2[q * 4 + e] * rstd * wv[e];
                *(f32x4*)(xr + col) = ov;
            } else {
                const f32x4 sc = *(const f32x4*)(modn + (size_t)b * 6144 + 1024 + col), sh = *(const f32x4*)(modn + (size_t)b * 6144 + col);
                f32x4 xo; float y[4];
#pragma unroll
                for (int e = 0; e < 4; ++e) { xo[e] = x2[q * 4 + e]; y[e] = x2[q * 4 + e] * rstd * wv[e] * (1.f + sc[e]) + sh[e]; }
                *(f32x4*)(xr + col) = xo;
                f32x2 ob; ((unsigned*)&ob)[0] = pkbf(y[0], y[1]); ((unsigned*)&ob)[1] = pkbf(y[2], y[3]);
                *(f32x2*)(XN + (size_t)t * 1024 + col) = ob;
            } }
    }
}

constexpr int N_PHASES = 1 + 11 * DEPTH;
#ifndef PH_MASK
#define PH_MASK 0xFFFF
#endif
#define PHON(k) (((PH_MASK) >> (k)) & 1)
__global__ void __launch_bounds__(NTHR, 2) mega(Args a) {
    extern __shared__ __attribute__((aligned(16))) unsigned char lds_raw[];
    LAS unsigned char* lds = (LAS unsigned char*)lds_raw;
    const int tid0 = threadIdx.x, bid = blockIdx.x, G = gridDim.x;
    const int NGW = G * NWAVES, NGT = G * NTHR;
    unsigned char* ws = a.ws;
    volatile LAS unsigned* MISC = (volatile LAS unsigned*)(lds + LDSCTL_OFF);
    for (int u = tid0; u < (LDS_BYTES - LDSCTL_OFF) / 4; u += NTHR) MISC[u] = 0u;
    __syncthreads();
    const int lo = a.ph_lo, hi = a.ph_hi;
    XcdBarrier bar; bar.bar = (unsigned*)(ws + WS_CTL) + CW_BAR; bar.x = 0; bar.st = nullptr;
    if (hi - lo > 1) bar = xcd_barrier_post((unsigned*)(ws + WS_CTL) + CW_BAR, MISC + 8);
#define IN(k) (lo <= (k) && (k) < hi)
#define SEAM(k) do { if (IN(k) && IN((k) + 1)) xcd_barrier(bar); } while (0)

    float* MOD = (float*)(ws + WS_MOD);
    bf16* XN = (bf16*)(ws + WS_XN);
    bf16* Qb = (bf16*)(ws + WS_Q); bf16* Kb = (bf16*)(ws + WS_K); bf16* Vb = (bf16*)(ws + WS_V); bf16* UPb = (bf16*)(ws + WS_UP); bf16* GAb = (bf16*)(ws + WS_GA); bf16* GPb = (bf16*)(ws + WS_GP);
    bf16* Mb = (bf16*)(ws + WS_XN);
    bf16* QPb = (bf16*)(ws + WS_PROJ);
    int* EIDX = (int*)(ws + WS_EIDX); float* GSb = (float*)(ws + WS_GS);
    bf16* EUb = (bf16*)(ws + WS_EXPU); bf16* EVb = (bf16*)(ws + WS_EXPV);

    if (PHON(0) && IN(0)) { p0_prologue(a, lds, tid0, tid0 & 63, __builtin_amdgcn_readfirstlane(tid0 >> 6), bid, G); }
    SEAM(0);

    for (int l = 0; l < DEPTH; ++l) {
        const int pb = 1 + 11 * l;
        int tid = tid0; asm volatile("" : "+v"(tid));
        const int lane = tid & 63, wave = __builtin_amdgcn_readfirstlane(tid >> 6), gw = bid * NWAVES + wave, gt = bid * NTHR + tid;
        const float* modl = MOD + (size_t)l * 4 * 6144;
        const float* Xin = (l == 0) ? a.x : a.out;
        if (PHON(1) && IN(pb + 0) && l == 0) normmod_phase(a.x, a.norm_mix_w, modl, 0, 1024, XN, gw, NGW, lane);
        SEAM(pb + 0);
        if (PHON(2) && IN(pb + 1)) {
            pg8::Gemm g{XN, (const bf16*)(ws + WS_WIN) + (size_t)l * 4096 * 1024, TOK, INC, DM}; pg8::StaticOrder S; S.init(TOK, INC, G, bid);
            pg8::EpiB<1> E{nullptr, 0, nullptr, nullptr, Qb, Kb, Vb, UPb, GAb, GPb};
            pg8::gemm_phase<pg8::EpiB<1>, pg8::StaticOrder, true, true>(lds, g, S, E);
        }
        SEAM(pb + 1);
        if (PHON(3) && IN(pb + 2)) {
            qknorm_rope_phase(Qb, Kb, a.q_norm_w + l * 128, a.k_norm_w + l * 128, (const f32x2*)(ws + WS_ROPE), gw, NGW, lane);
            poolwin_phase(UPb, Mb, gt, NGT);
            if (l == 1) { cvt8_range(a.expert_u + (size_t)NEXP * 1024, EUb, (size_t)NEXP * 1024 / 8, gt, NGT); cvt8_range(a.expert_v + (size_t)NEXP * 1024, EVb, (size_t)NEXP * 1024 / 8, gt, NGT); }
        }
        SEAM(pb + 2);
        if (PHON(4) && IN(pb + 3)) {
            for (int i = 0;; ++i) {
                int x, g, qb;
                if (G == 256) { if (i >= 4) break; x = bid & 7; g = i; qb = bid >> 3; }
                else { const int u = bid + i * G; if (u >= 1024) break; x = u >> 7; g = (u & 127) >> 5; qb = u & 31; }
                const int b = x >> 1, kvh = x & 1, h = kvh * 4 + g;
                bf16* q0 = Qb + ((size_t)(b * SEQ + qb * 256)) * 1024 + h * 128;
                const bf16* k0 = Kb + ((size_t)b * SEQ) * 256 + kvh * 128; const bf16* v0 = Vb + ((size_t)b * SEQ) * 256 + kvh * 128;
                att::attn_dense_body<att::bf16>(q0, k0, v0, q0, SEQ, (char*)lds_raw);
                __syncthreads();
            }
        }
        SEAM(pb + 3);
        if (PHON(5) && IN(pb + 4)) {
            { pg8::Gemm g{Qb, (const bf16*)(ws + WS_WAO) + (size_t)l * 1024 * 1024, TOK, DM, DM}; pg8::StaticOrder S; S.init(TOK, DM, G, bid);
              pg8::EpiB<2> E{GAb, 1024, nullptr, nullptr, nullptr, nullptr, nullptr, nullptr, nullptr, nullptr};
              pg8::gemm_phase<pg8::EpiB<2>, pg8::StaticOrder, true, true>(lds, g, S, E); }
            __syncthreads();
            { pg8::Gemm g{Mb, (const bf16*)(ws + WS_WMIX) + (size_t)l * 512 * 512, TOK, POOLW, POOLW}; pg8::StaticOrder S; S.init(TOK, POOLW, G, bid);
              pg8::EpiB<3> E{UPb, 512, nullptr, a.pool_scale + l * 512, nullptr, nullptr, nullptr, nullptr, nullptr, nullptr};
              pg8::gemm_phase<pg8::EpiB<3>, pg8::StaticOrder, true, true>(lds, g, S, E); }
        }
        SEAM(pb + 4);
        if (PHON(6) && IN(pb + 5)) {
            pg8::Gemm g{UPb, (const bf16*)(ws + WS_WPO) + (size_t)l * 1024 * 512, TOK, DM, POOLW}; pg8::StaticOrder S; S.init(TOK, DM, G, bid);
            pg8::EpiB<4> E{GPb, 1024, GAb, nullptr, nullptr, nullptr, nullptr, nullptr, nullptr, nullptr};
            pg8::gemm_phase<pg8::EpiB<4>, pg8::StaticOrder, true, true>(lds, g, S, E);
        }
        SEAM(pb + 5);
        if (PHON(7) && IN(pb + 6)) {
            pg8::Gemm g{GPb, (const bf16*)(ws + WS_WOUT) + (size_t)l * 1024 * 1024, TOK, DM, DM}; pg8::StaticOrder S; S.init(TOK, DM, G, bid);
            pg8::EpiResid E{Xin, a.out, modl + 2048};
            pg8::gemm_phase<pg8::EpiResid, pg8::StaticOrder, true, true>(lds, g, S, E);
        }
        SEAM(pb + 6);
        if (PHON(8) && IN(pb + 7)) normmod_phase(a.out, a.norm_ffn_w + l * 1024, modl, 3072, 4096, XN, gw, NGW, lane);
        SEAM(pb + 7);
        if (PHON(9) && IN(pb + 8)) {
            pg8::Gemm g{XN, (const bf16*)(ws + WS_WQ) + (size_t)l * 4096 * 1024, TOK, PH * PQD, DM}; pg8::StaticOrder S; S.init(TOK, PH * PQD, G, bid);
            pg8::EpiB<0> E{QPb, 4096, nullptr, nullptr, nullptr, nullptr, nullptr, nullptr, nullptr, nullptr};
            pg8::gemm_phase<pg8::EpiB<0>, pg8::StaticOrder, true, true>(lds, g, S, E);
        }
        SEAM(pb + 8);
        if (PHON(10) && IN(pb + 9)) topk_phase(QPb, (const bf16*)(ws + WS_SUBK) + (size_t)l * (8 * 2 * 128 * 256), EIDX, GSb, lds, tid, lane, wave, bid, G);
        SEAM(pb + 9);
        if (PHON(11) && IN(pb + 10)) {
            if (l == 0) gather_phase<false>(XN, EIDX, GSb, EUb, EVb, a.out, modl + 5120, a.norm_mix_w + 1024, MOD + (size_t)4 * 6144, XN, gw, NGW, lane);
            else gather_phase<true>(XN, EIDX, GSb, EUb, EVb, a.out, modl + 5120, a.final_norm_w, nullptr, XN, gw, NGW, lane);
        }
        SEAM(pb + 10);
    }
#undef IN
#undef SEAM
}

extern "C" void kernel_launch(void* const* d_in, const int* in_sizes, int n_in, void* d_out, int out_size, void* d_ws, size_t ws_size, hipStream_t stream) {
    static int grid = 0;
    if (grid == 0) {
        if (n_in != 19 || in_sizes[0] != TOK * DM || out_size != TOK * DM || ws_size < WS_END) {
            fprintf(stderr, "kernel_launch: unexpected shapes: n_in %d in0 %d out %d ws %zu (need %zu); nothing launched\n", n_in, n_in > 0 ? in_sizes[0] : -1, out_size, ws_size, (size_t)WS_END); grid = -1; return; }
        int dev = 0, cus = 0, per_cu = 0;
        if (hipGetDevice(&dev) != hipSuccess || hipDeviceGetAttribute(&cus, hipDeviceAttributeMultiprocessorCount, dev) != hipSuccess) { grid = -1; return; }
        if (hipFuncSetAttribute((const void*)mega, hipFuncAttributeMaxDynamicSharedMemorySize, LDS_BYTES) != hipSuccess) { fprintf(stderr, "kernel_launch: hipFuncSetAttribute failed\n"); grid = -1; return; }
        if (hipOccupancyMaxActiveBlocksPerMultiprocessor(&per_cu, (const void*)mega, NTHR, LDS_BYTES) != hipSuccess || per_cu < 1) {
            fprintf(stderr, "kernel_launch: occupancy query says %d blocks per CU; nothing launched\n", per_cu); (void)hipGetLastError(); grid = -1; return; }
        grid = cus;
    }
    if (grid < 0) return;
    (void)hipMemsetAsync((char*)d_ws + WS_CTL, 0, CTL_ZERO_BYTES, stream);
    Args a; memset(&a, 0, sizeof(a));
    const float** ap = (const float**)&a;
    for (int i = 0; i < 19; ++i) ap[i] = (const float*)d_in[i];
    a.out = (float*)d_out; a.ws = (unsigned char*)d_ws;
#if MK_ONE_LAUNCH
    a.ph_lo = 0; a.ph_hi = N_PHASES;
    hipLaunchKernelGGL(mega, dim3(grid), dim3(NTHR), LDS_BYTES, stream, a);
#else
    for (int p = 0; p < N_PHASES; ++p) {
        if (p == 1 + 11) continue;
        a.ph_lo = p; a.ph_hi = p + 1;
        hipLaunchKernelGGL(mega, dim3(grid), dim3(NTHR), LDS_BYTES, stream, a);
    }
#endif
    const hipError_t le = hipPeekAtLastError();
    if (le != hipSuccess) fprintf(stderr, "kernel_launch: launch failed: %s\n", hipGetErrorName(le));
}
```

```cpp
#include <hip/hip_runtime.h>
#include <cstdio>
#include <cstdint>
#include <cstring>

#ifndef MK_ONE_LAUNCH
#define MK_ONE_LAUNCH 1
#endif

constexpr int DM = 1024, NB = 4, SEQ = 8192, TOK = NB * SEQ, DEPTH = 2;
constexpr int HD = 128, NH = 8, NKV = 2, KVW = 256, POOLW = 512, INC = 4096;
constexpr int PH = 8, PQD = 512, SUBD = 256, NKEYS = 128, NEXP = 16384, TOPK = 16;
constexpr int NADA = 6;
constexpr float EPS = 1e-6f;

constexpr size_t MiB = 1u << 20;
constexpr size_t WS_CTL = 0, CTL_ZERO_BYTES = 128 * 1024;
constexpr size_t WS_MOD = 1 * MiB;
constexpr size_t WS_ROPE = WS_MOD + 256 * 1024;
constexpr size_t WS_WIN = 2 * MiB;
constexpr size_t WS_WAO = WS_WIN + 16 * MiB;
constexpr size_t WS_WPO = WS_WAO + 4 * MiB;
constexpr size_t WS_WOUT = WS_WPO + 2 * MiB;
constexpr size_t WS_WQ = WS_WOUT + 4 * MiB;
constexpr size_t WS_SUBK = WS_WQ + 16 * MiB;
constexpr size_t WS_WMIX = WS_SUBK + 2 * MiB;
constexpr size_t WS_EXPU = 48 * MiB;
constexpr size_t WS_EXPV = WS_EXPU + 32 * MiB;
constexpr size_t WS_XN = 112 * MiB;
constexpr size_t WS_PROJ = 176 * MiB;
constexpr size_t WS_Q = WS_PROJ, WS_K = WS_Q + 64 * MiB, WS_V = WS_K + 16 * MiB, WS_UP = WS_V + 16 * MiB, WS_GA = WS_UP + 32 * MiB, WS_GP = WS_GA + 64 * MiB;
constexpr size_t WS_EIDX = 432 * MiB;
constexpr size_t WS_GS = WS_EIDX + 16 * MiB;
constexpr size_t WS_XQ = WS_GS + 16 * MiB;
constexpr size_t WS_K8 = WS_XN + 32 * MiB;
constexpr size_t WS_V8T = WS_K8 + 8 * MiB;
constexpr size_t WS_SX = WS_XQ + 32 * MiB;
constexpr size_t WS_SU = WS_SX + 256 * 1024;
constexpr size_t WS_SX2 = WS_SX + 128 * 1024;
constexpr size_t WS_SWIN = WS_SU + 128 * 1024;
constexpr size_t WS_SWQ = WS_SWIN + 32 * 1024;
constexpr size_t WS_ABD = WS_PROJ;
constexpr size_t WS_WQB = WS_PROJ + 32 * MiB;
constexpr size_t WS_WC = WS_WQ;
constexpr size_t WS_WC8 = WS_WQ + 8 * MiB;
constexpr size_t WS_SWC = WS_SWQ;
constexpr size_t WS_XQ2 = WS_XN;
constexpr size_t WS_END = WS_SX + 1 * MiB;
static_assert(WS_WMIX + 1 * MiB <= WS_EXPU && WS_GP + 64 * MiB == WS_EIDX, "d_ws map");

namespace pg8 {
#define PG8_LAS __attribute__((address_space(3)))
typedef unsigned short bf16_t;
typedef short bf16x8 __attribute__((ext_vector_type(8)));
typedef float f32x4 __attribute__((ext_vector_type(4)));
typedef unsigned u32x4 __attribute__((ext_vector_type(4)));
typedef int i32x4_t __attribute__((ext_vector_type(4)));
constexpr int BM = 256, BK = 64, HALF = 128, HTB = HALF * BK * 2  , STAGE_BYTES = 8 * HTB, NXCD = 8, WGM = 8;

__host__ __device__ __forceinline__ int lds_byte(int r, int c) { const int st = (r >> 4) * 2 + (c >> 5), rr = r & 15, cc = c & 31, ob = rr * 64 + cc * 2; return st * 1024 + (ob ^ (((ob >> 9) & 1) << 5)); }
__host__ __device__ __forceinline__ void stage_rc(int b, int& R, int& C) { const int st = b / 1024, sb = b % 1024, swz = sb ^ (((sb >> 9) & 1) << 5); R = (st >> 1) * 16 + swz / 64; C = (st & 1) * 32 + (swz % 64) / 2; }
__host__ __device__ __forceinline__ int perm32(int rho) { const int n = rho >> 4, i = rho & 15; return 8 * (i >> 2) + 4 * n + (i & 3); }

struct Unit { int pm, pn; };
struct Gemm { const bf16_t* A; const bf16_t* Bt; int M, N, K; int KT, kshift; };

struct StaticOrder {
    int nM, nN, nwg, G, c;
    __host__ __device__ void init(int M, int N, int G_, int c_) { nM = M / BM; nN = N / BM; nwg = nM * nN; G = G_; c = c_; }
    __host__ __device__ bool next(int i, Unit& u) const {
        const long L = (long)i * G + c; if (L >= nwg) return false;
        int wgid = (int)L; { const int q = nwg / NXCD, r = nwg % NXCD, xcd = wgid % NXCD, off = wgid / NXCD; wgid = (xcd < r ? xcd * (q + 1) : r * (q + 1) + (xcd - r) * q) + off; }
        const int nig = WGM * nN, gid = wgid / nig, fm = gid * WGM, gsz = (nM - fm) < WGM ? (nM - fm) : WGM;
        u.pm = fm + ((wgid % nig) % gsz); u.pn = (wgid % nig) / gsz; return true;
    }
    __device__ __forceinline__ void a_ready(const Unit&) const {}
    __device__ __forceinline__ void done(const Unit&) const {}
};

__device__ __forceinline__ unsigned cvt_pk_bf16(float lo, float hi) { unsigned r; asm volatile("v_cvt_pk_bf16_f32 %0, %1, %2" : "=v"(r) : "v"(lo), "v"(hi)); return r; }
__device__ __forceinline__ float bflo(unsigned w) { return __builtin_bit_cast(float, w << 16); }
__device__ __forceinline__ float bfhi(unsigned w) { return __builtin_bit_cast(float, w & 0xffff0000u); }
__device__ __forceinline__ float sigm(float x) { return __builtin_amdgcn_rcpf(1.f + __expf(-x)); }

template <int MODE> struct EpiB {
    static constexpr bool PERM = true, AFTER_DRAIN = false;
    bf16_t* O; int ldc; const bf16_t* T1; const float* scale;
    bf16_t *pq, *pk, *pv, *pup, *pga, *pgp;
    const float *srow, *scol;
    __device__ __forceinline__ void operator()(const f32x4 (&acc)[2][2][4][2], const Unit& u, int wr, int wc, int fr, int fq) const {
        const int row0 = u.pm * BM + wr * 64 + fr; int colt = u.pn * BM; bf16_t* base = O; int ld = ldc;
        if (MODE == 1) {
            const int pn = u.pn;
            if (pn < 4) { base = pq; ld = 1024; colt = pn * 256; }
            else if (pn == 4) { base = pk; ld = 256; colt = 0; }
            else if (pn == 5) { base = pv; ld = 256; colt = 0; }
            else if (pn < 8) { base = pup; ld = 512; colt = (pn - 6) * 256; }
            else if (pn < 12) { base = pga; ld = 1024; colt = (pn - 8) * 256; }
            else { base = pgp; ld = 1024; colt = (pn - 12) * 256; }
        }
        const int col0 = colt + wc * 32 + 8 * fq;
        f32x4 sv[2][2];
        if (MODE == 1 || MODE == 5 || MODE == 6) {
#pragma unroll
            for (int bj = 0; bj < 2; ++bj)
#pragma unroll
                for (int n = 0; n < 2; ++n) sv[bj][n] = *(const f32x4*)(scol + u.pn * BM + wc * 32 + 8 * fq + bj * HALF + 4 * n);
        }
        if (MODE == 3) {
#pragma unroll
            for (int bj = 0; bj < 2; ++bj)
#pragma unroll
                for (int n = 0; n < 2; ++n) sv[bj][n] = *(const f32x4*)(scale + col0 + bj * HALF + 4 * n);
        }
#pragma unroll
        for (int ai = 0; ai < 2; ++ai)
#pragma unroll
            for (int m = 0; m < 4; ++m) {
                const size_t roff = (size_t)(row0 + ai * HALF + m * 16) * ld + col0;
#pragma unroll
                for (int bj = 0; bj < 2; ++bj) {
                    f32x4 v0 = acc[ai][bj][m][0], v1 = acc[ai][bj][m][1];
                    if (MODE == 1 || MODE == 5 || MODE == 6) { const float sr = srow[row0 + ai * HALF + m * 16]; const i32x4_t i0 = __builtin_bit_cast(i32x4_t, v0), i1 = __builtin_bit_cast(i32x4_t, v1);
                        v0 = f32x4{(float)i0[0], (float)i0[1], (float)i0[2], (float)i0[3]} * sv[bj][0] * sr; v1 = f32x4{(float)i1[0], (float)i1[1], (float)i1[2], (float)i1[3]} * sv[bj][1] * sr; }
                    bf16_t* p = base + roff + bj * HALF;
                    if (MODE == 5) { const int row = row0 + ai * HALF + m * 16, chunk = wc * 4 + fq + bj * 16; p = base + ((((size_t)(row >> 5) * 16 + u.pn) * 32 + chunk) * 32 + (row & 31)) * 8; }
                    if (MODE == 3) { v0 = v0 * sv[bj][0]; v1 = v1 * sv[bj][1]; }
                    if (MODE == 2 || MODE == 4) {
                        const u32x4 g = *(const u32x4*)p;
                        v0[0] *= sigm(bflo(g.x)); v0[1] *= sigm(bfhi(g.x)); v0[2] *= sigm(bflo(g.y)); v0[3] *= sigm(bfhi(g.y));
                        v1[0] *= sigm(bflo(g.z)); v1[1] *= sigm(bfhi(g.z)); v1[2] *= sigm(bflo(g.w)); v1[3] *= sigm(bfhi(g.w));
                    }
                    if (MODE == 4) {
                        const u32x4 t = *(const u32x4*)(T1 + roff + bj * HALF);
                        v0[0] += bflo(t.x); v0[1] += bfhi(t.x); v0[2] += bflo(t.y); v0[3] += bfhi(t.y);
                        v1[0] += bflo(t.z); v1[1] += bfhi(t.z); v1[2] += bflo(t.w); v1[3] += bfhi(t.w);
                    }
                    u32x4 w; w.x = cvt_pk_bf16(v0[0], v0[1]); w.y = cvt_pk_bf16(v0[2], v0[3]); w.z = cvt_pk_bf16(v1[0], v1[1]); w.w = cvt_pk_bf16(v1[2], v1[3]);
                    if (MODE == 6) {
                        const int row = row0 + ai * HALF + m * 16; bf16_t* q = base + ((((((size_t)(row >> 5) * 8 + u.pn) * 2 + bj) * 4 + wc) * 2) * 32 + (row & 31)) * 16 + 4 * fq;
                        *(unsigned long long*)q = (unsigned long long)w.x | ((unsigned long long)w.y << 32); *(unsigned long long*)(q + 512) = (unsigned long long)w.z | ((unsigned long long)w.w << 32); }
                    else *(u32x4*)p = w;
                }
            }
    }
};

struct EpiResid {
    static constexpr bool PERM = false, AFTER_DRAIN = false;
    const float* Xin; bf16_t* XS; const float* gate; int xin_bf;
    __device__ __forceinline__ void operator()(const f32x4 (&acc)[2][2][4][2], const Unit& u, int wr, int wc, int fr, int fq) const {
        const int row0 = u.pm * BM + wr * 64 + fr, colb = u.pn * BM + wc * 32 + 4 * fq;
        const float* gp = gate + (size_t)((u.pm * BM) >> 13) * 6144;
        f32x4 gv[2][2];
#pragma unroll
        for (int bj = 0; bj < 2; ++bj)
#pragma unroll
            for (int n = 0; n < 2; ++n) gv[bj][n] = *(const f32x4*)(gp + colb + bj * HALF + 16 * n);
#pragma unroll
        for (int ai = 0; ai < 2; ++ai)
#pragma unroll
            for (int m = 0; m < 4; ++m) {
                const size_t row = (size_t)(row0 + ai * HALF + m * 16);
#pragma unroll
                for (int bj = 0; bj < 2; ++bj)
#pragma unroll
                    for (int n = 0; n < 2; ++n) { const int col = colb + bj * HALF + 16 * n;
                        bf16_t* sp = XS + row * 2048 + 1024 + col;
                        f32x4 xi;
                        if (xin_bf) { const unsigned long long raw = *(const unsigned long long*)sp; const unsigned lo = (unsigned)raw, hi = (unsigned)(raw >> 32); xi = f32x4{bflo(lo), bfhi(lo), bflo(hi), bfhi(hi)}; }
                        else xi = *(const f32x4*)(Xin + row * 1024 + col);
                        const f32x4 y = xi + gv[bj][n] * acc[ai][bj][m][n];
                        *(unsigned long long*)sp = (unsigned long long)cvt_pk_bf16(y[0], y[1]) | ((unsigned long long)cvt_pk_bf16(y[2], y[3]) << 32); }
            }
    }
};

template <class Epi, class Sched, bool ALIGN_EPI = false, bool SP2 = false, bool I8 = false>
__device__ __forceinline__ void gemm_phase(PG8_LAS unsigned char* lds, const Gemm g, const Sched& S, const Epi& E) {
    int tid = threadIdx.x; asm volatile("" : "+v"(tid));
    const int wid = __builtin_amdgcn_readfirstlane(tid >> 6), lane = tid & 63, wr = wid >> 2, wc = wid & 3, fr = lane & 15, fq = lane >> 4;
    const int K = g.K, nt = g.KT ? g.KT : K / BK;
    unsigned voffA[2], voffB[2];
#pragma unroll
    for (int i = 0; i < 2; ++i) { int R, C; stage_rc(tid * 16 + i * 8192, R, C); const int Rb = Epi::PERM ? ((R & ~31) + perm32(R & 31)) : R;
        voffA[i] = (unsigned)(R * K + C) * 2u; voffB[i] = (unsigned)(Rb * K + C) * 2u; }
    const size_t kstep = (size_t)(BK * 2);
    const size_t hstep = (size_t)HALF * K * 2;
    const size_t tstep = 2 * hstep;
    const unsigned ldsw = (unsigned)wid * 1024u;
    const int aoff = lds_byte(wr * 64 + fr, fq * 8), boff = lds_byte(wc * 32 + fr, fq * 8);
#define PG8_SA(b, h) (((b) * 2 + (h)) * HTB)
#define PG8_SB(b, h) ((4 + (b) * 2 + (h)) * HTB)
#define PG8_STAGE(bufoff, gbase, voff) do { _Pragma("unroll") for (int _i = 0; _i < 2; ++_i) \
        __builtin_amdgcn_global_load_lds((const unsigned*)((const char*)(gbase) + (voff)[_i]), (PG8_LAS unsigned*)(lds + (bufoff) + ldsw + _i * 8192), 16, 0, 0); } while (0)
#define PG8_LDA(dst, b, h) do { _Pragma("unroll") for (int m = 0; m < 4; ++m) _Pragma("unroll") for (int k = 0; k < 2; ++k) dst[m][k] = *(const PG8_LAS bf16x8*)(lds + PG8_SA(b, h) + aoff + m * 2048 + k * 1024); } while (0)
#define PG8_LDB(dst, b, h) do { _Pragma("unroll") for (int n = 0; n < 2; ++n) _Pragma("unroll") for (int k = 0; k < 2; ++k) dst[n][k] = *(const PG8_LAS bf16x8*)(lds + PG8_SB(b, h) + boff + n * 2048 + k * 1024); } while (0)
#define PG8_MMA(ai, bj, At, Bt) do { __builtin_amdgcn_s_setprio(1); _Pragma("unroll") for (int m = 0; m < 4; ++m) _Pragma("unroll") for (int n = 0; n < 2; ++n) _Pragma("unroll") for (int k = 0; k < 2; ++k) \
        { if constexpr (I8) acc[ai][bj][m][n] = __builtin_bit_cast(f32x4, __builtin_amdgcn_mfma_i32_16x16x64_i8(__builtin_bit_cast(i32x4_t, Bt[n][k]), __builtin_bit_cast(i32x4_t, At[m][k]), __builtin_bit_cast(i32x4_t, acc[ai][bj][m][n]), 0, 0, 0)); \
          else acc[ai][bj][m][n] = __builtin_amdgcn_mfma_f32_16x16x32_bf16(Bt[n][k], At[m][k], acc[ai][bj][m][n], 0, 0, 0); } __builtin_amdgcn_s_setprio(0); } while (0)
#define PG8_WAIT_V(n) asm volatile("s_waitcnt vmcnt(" #n ")" ::: "memory")
#define PG8_WAIT_L(n) asm volatile("s_waitcnt lgkmcnt(" #n ")" ::: "memory")
#define PG8_BAR __builtin_amdgcn_s_barrier()
#define PG8_SCHED __builtin_amdgcn_sched_barrier(0)
    Unit cur, nxt; int ui = 0;
    if (!S.next(0, cur)) return;
    f32x4 acc[2][2][4][2];
#pragma unroll
    for (int a = 0; a < 2; ++a)
#pragma unroll
        for (int b = 0; b < 2; ++b)
#pragma unroll
            for (int m = 0; m < 4; ++m)
#pragma unroll
                for (int n = 0; n < 2; ++n) acc[a][b][m][n] = (f32x4){0.f, 0.f, 0.f, 0.f};
    bf16x8 At[4][2], B0[2][2], B1[2][2];
    const char* cA = (const char*)g.A + (size_t)cur.pm * tstep + (size_t)cur.pm * g.kshift; const char* cB = (const char*)g.Bt + (size_t)cur.pn * tstep + (size_t)cur.pm * g.kshift;
    S.a_ready(cur);
    if constexpr (SP2) {
        PG8_STAGE(PG8_SB(0, 0), cB, voffB); PG8_STAGE(PG8_SB(0, 1), cB + hstep, voffB); PG8_STAGE(PG8_SA(0, 0), cA, voffA); PG8_STAGE(PG8_SA(0, 1), cA + hstep, voffA);
        if (wr == 1) PG8_BAR;
        PG8_WAIT_V(2); PG8_BAR;
        PG8_STAGE(PG8_SB(1, 0), cB + kstep, voffB); PG8_STAGE(PG8_SA(1, 0), cA + kstep, voffA); PG8_STAGE(PG8_SB(1, 1), cB + hstep + kstep, voffB);
        PG8_WAIT_V(6); PG8_BAR;
    } else {
        PG8_STAGE(PG8_SB(0, 0), cB, voffB); PG8_STAGE(PG8_SA(0, 0), cA, voffA); PG8_STAGE(PG8_SB(0, 1), cB + hstep, voffB); PG8_STAGE(PG8_SA(0, 1), cA + hstep, voffA);
        if (wr == 1) PG8_BAR;
        PG8_WAIT_V(4); PG8_BAR;
        PG8_STAGE(PG8_SB(1, 0), cB + kstep, voffB); PG8_STAGE(PG8_SA(1, 0), cA + kstep, voffA); PG8_STAGE(PG8_SB(1, 1), cB + hstep + kstep, voffB);
        PG8_WAIT_V(6); PG8_BAR;
    }
    for (;;) {
        const bool has_next = S.next(ui + 1, nxt);
        const char* nA = has_next ? (const char*)g.A + (size_t)nxt.pm * tstep + (size_t)nxt.pm * g.kshift : cA; const char* nB = has_next ? (const char*)g.Bt + (size_t)nxt.pn * tstep + (size_t)nxt.pm * g.kshift : cB;
        for (int t = 0; t < nt; t += 2) {
            const bool last = (t == nt - 2);
            const char* a1 = cA + (size_t)(t + 1) * kstep;
            const char* a2 = last ? nA : cA + (size_t)(t + 2) * kstep; const char* b2 = last ? nB : cB + (size_t)(t + 2) * kstep;
            const char* a3 = a2 + kstep; const char* b3 = b2 + kstep;
            if (last && has_next) S.a_ready(nxt);
            if constexpr (SP2) {
            PG8_LDB(B0, 0, 0); PG8_LDB(B1, 0, 1); PG8_SCHED; PG8_LDA(At, 0, 0); PG8_STAGE(PG8_SA(1, 1), a1 + hstep, voffA);
            PG8_WAIT_V(8); PG8_WAIT_L(0); PG8_BAR; PG8_MMA(0, 0, At, B0); PG8_MMA(0, 1, At, B1); PG8_BAR; PG8_SCHED;
            PG8_LDA(At, 0, 1); PG8_STAGE(PG8_SB(0, 0), b2, voffB); PG8_STAGE(PG8_SB(0, 1), b2 + hstep, voffB); PG8_STAGE(PG8_SA(0, 0), a2, voffA);
            PG8_WAIT_V(8); PG8_WAIT_L(0); PG8_BAR; PG8_MMA(1, 0, At, B0); PG8_MMA(1, 1, At, B1); PG8_BAR; PG8_SCHED;
            PG8_LDB(B0, 1, 0); PG8_LDB(B1, 1, 1); PG8_SCHED; PG8_LDA(At, 1, 0); PG8_STAGE(PG8_SA(0, 1), a2 + hstep, voffA);
            PG8_WAIT_V(8); PG8_WAIT_L(0); PG8_BAR; PG8_MMA(0, 0, At, B0); PG8_MMA(0, 1, At, B1); PG8_BAR; PG8_SCHED;
            PG8_LDA(At, 1, 1); PG8_STAGE(PG8_SB(1, 0), b3, voffB); PG8_STAGE(PG8_SB(1, 1), b3 + hstep, voffB); PG8_STAGE(PG8_SA(1, 0), a3, voffA);
            PG8_WAIT_V(8); PG8_WAIT_L(0); PG8_BAR; PG8_MMA(1, 0, At, B0); PG8_MMA(1, 1, At, B1); PG8_BAR; PG8_SCHED;
            } else {
            PG8_LDB(B0, 0, 0); PG8_SCHED; PG8_LDA(At, 0, 0); PG8_STAGE(PG8_SA(1, 1), a1 + hstep, voffA);
            PG8_WAIT_L(8); PG8_BAR; PG8_WAIT_L(0); PG8_MMA(0, 0, At, B0); PG8_BAR; PG8_SCHED;
            PG8_LDB(B1, 0, 1); PG8_STAGE(PG8_SB(0, 0), b2, voffB);
            PG8_BAR; PG8_WAIT_L(0); PG8_MMA(0, 1, At, B1); PG8_BAR;
            PG8_LDA(At, 0, 1); PG8_STAGE(PG8_SA(0, 0), a2, voffA);
            PG8_BAR; PG8_WAIT_L(0); PG8_MMA(1, 0, At, B0); PG8_BAR; PG8_SCHED;
            PG8_STAGE(PG8_SB(0, 1), b2 + hstep, voffB);
            PG8_WAIT_V(6); PG8_BAR; PG8_MMA(1, 1, At, B1); PG8_BAR;
            PG8_LDB(B0, 1, 0); PG8_SCHED; PG8_LDA(At, 1, 0); PG8_STAGE(PG8_SA(0, 1), a2 + hstep, voffA);
            PG8_WAIT_L(8); PG8_BAR; PG8_WAIT_L(0); PG8_MMA(0, 0, At, B0); PG8_BAR; PG8_SCHED;
            PG8_LDB(B1, 1, 1); PG8_STAGE(PG8_SB(1, 0), b3, voffB);
            PG8_BAR; PG8_WAIT_L(0); PG8_MMA(0, 1, At, B1); PG8_BAR;
            PG8_LDA(At, 1, 1); PG8_STAGE(PG8_SA(1, 0), a3, voffA);
            PG8_BAR; PG8_WAIT_L(0); PG8_MMA(1, 0, At, B0); PG8_BAR; PG8_SCHED;
            PG8_STAGE(PG8_SB(1, 1), b3 + hstep, voffB);
            PG8_WAIT_V(6); PG8_BAR; PG8_MMA(1, 1, At, B1); PG8_BAR;
            }
        }
        if constexpr (ALIGN_EPI) { if (wr == 0) PG8_BAR; }
        if constexpr (!Epi::AFTER_DRAIN) { E(acc, cur, wr, wc, fr, fq); S.done(cur); }
        if (!has_next) break;
#pragma unroll
        for (int a = 0; a < 2; ++a)
#pragma unroll
            for (int b = 0; b < 2; ++b)
#pragma unroll
                for (int m = 0; m < 4; ++m)
#pragma unroll
                    for (int n = 0; n < 2; ++n) acc[a][b][m][n] = (f32x4){0.f, 0.f, 0.f, 0.f};
        cur = nxt; cA = nA; cB = nB; ++ui;
        if constexpr (ALIGN_EPI) { if (wr == 1) PG8_BAR; }
    }
    PG8_WAIT_V(0);
    if constexpr (!ALIGN_EPI) { if (wr == 0) PG8_BAR; }
    PG8_BAR;
    if constexpr (Epi::AFTER_DRAIN) { E.fused(acc, cur, wr, wc, fr, fq, lds, wid, lane); S.done(cur); }
#undef PG8_SA
#undef PG8_SB
#undef PG8_STAGE
#undef PG8_LDA
#undef PG8_LDB
#undef PG8_MMA
#undef PG8_WAIT_V
#undef PG8_WAIT_L
#undef PG8_BAR
#undef PG8_SCHED
}
}
namespace att {
typedef unsigned short bf16;
constexpr int   D = 128, NW = 8, QBLK = 32, KVBLK = 64;
constexpr float SCALE = 0.088388347648318440f;
constexpr float THR = 8.f;
constexpr int SDEPTH = 1;
constexpr int LDQ = 1024, LDK = 256, LDO = 1024;
constexpr size_t SHM_V = KVBLK * D * 2, SHM_K = KVBLK * D * 2, SHM_ATTN = 3 * SHM_V + 3 * SHM_K + NW * 64 * 4;
using bf16x8 = __attribute__((ext_vector_type(8))) short;
using s16x4  = __attribute__((ext_vector_type(4))) short;
using f32x16 = __attribute__((ext_vector_type(16))) float;
using f32x8  = __attribute__((ext_vector_type(8))) float;
using u32x4  = __attribute__((ext_vector_type(4))) unsigned;
using i32x8  = __attribute__((ext_vector_type(8))) int;
constexpr size_t SHM_K8 = KVBLK * D;
#define KSWZ8(row, colB) ((row) * 128 + ((colB) ^ ((((row) >> 1) & 7) << 4)))
constexpr size_t SHM_V8 = KVBLK * D;
#define V8SWZ(d, colB) ((d) * 64 + ((colB) ^ ((((d) >> 2) & 3) << 4)))
#define KSWZ(row, colB) ((row) * 256 + ((colB) ^ (((row) & 15) << 4)))
#define SBAR() __builtin_amdgcn_sched_barrier(0)
#define ATT_LAS __attribute__((address_space(3)))
__device__ __forceinline__ int crow(int r, int hi) { return (r & 3) + 8 * (r >> 2) + 4 * hi; }
__device__ __forceinline__ unsigned cvtpk(float lo, float hi) {
  unsigned r; asm volatile("v_cvt_pk_bf16_f32 %0, %1, %2" : "=v"(r) : "v"(lo), "v"(hi)); return r;
}
template <typename TIn> struct Stage;
template <> struct Stage<bf16>  { using T = bf16x8;
  __device__ static __forceinline__ T ld8(const bf16* p) { return *reinterpret_cast<const bf16x8*>(p); }
  __device__ static __forceinline__ bf16x8 tobf(T x) { return x; } };

__device__ __forceinline__ void partialSM(f32x16& p0, f32x16& p1, float& m_reg, float& mn, float& alpha) {
  constexpr float C = 1.0f;
  float pmax = p0[0]; for (int r = 1; r < 16; ++r) pmax = fmaxf(pmax, p0[r]); for (int r = 0; r < 16; ++r) pmax = fmaxf(pmax, p1[r]);
  { auto rr = __builtin_amdgcn_permlane32_swap(__float_as_uint(pmax), __float_as_uint(pmax), false, false);
    pmax = fmaxf(__uint_as_float(rr[0]), __uint_as_float(rr[1])); }
  if (__builtin_expect(__all(pmax - m_reg <= THR * 1.4426950408889634f), 1)) { mn = m_reg; alpha = 1.f; }
  else { mn = fmaxf(m_reg, pmax); alpha = __builtin_amdgcn_exp2f((m_reg - mn) * C); m_reg = mn; }
  float mnC = -mn * C;
  for (int r = 0; r < 16; ++r) p0[r] = fmaf(p0[r], C, mnC); for (int r = 0; r < 16; ++r) p1[r] = fmaf(p1[r], C, mnC);
  for (int r = 0; r < 16; ++r) p0[r] = __builtin_amdgcn_exp2f(p0[r]);
}
__device__ __forceinline__ void finishSM(f32x16& p0, f32x16& p1, float alpha, float& l_reg, bf16x8& pa0, bf16x8& pa1, bf16x8& pa2, bf16x8& pa3) {
  for (int r = 0; r < 16; ++r) p1[r] = __builtin_amdgcn_exp2f(p1[r]);
  float ps = 0; for (int r = 0; r < 16; ++r) ps += p0[r]; for (int r = 0; r < 16; ++r) ps += p1[r];
  { auto rr = __builtin_amdgcn_permlane32_swap(__float_as_uint(ps), __float_as_uint(ps), false, false);
    ps = __uint_as_float(rr[0]) + __uint_as_float(rr[1]); }
  l_reg = l_reg * alpha + ps;
#define PK4(P, BASE, OUT) do { unsigned a0 = cvtpk(P[BASE + 0], P[BASE + 1]), a1 = cvtpk(P[BASE + 2], P[BASE + 3]);   \
    unsigned b0 = cvtpk(P[BASE + 4], P[BASE + 5]), b1 = cvtpk(P[BASE + 6], P[BASE + 7]);                              \
    auto r0 = __builtin_amdgcn_permlane32_swap(a0, b0, false, false); auto r1 = __builtin_amdgcn_permlane32_swap(a1, b1, false, false); \
    u32x4 w = {r0[0], r1[0], r0[1], r1[1]}; OUT = *reinterpret_cast<bf16x8*>(&w); } while (0)
  PK4(p0, 0, pa0); PK4(p0, 8, pa1); PK4(p1, 0, pa2); PK4(p1, 8, pa3);
#undef PK4
}
template <int ABL> __device__ __forceinline__ void partialSM_nm(f32x16& p0, f32x16& p1) { asm volatile("" : "+v"(p0), "+v"(p1));
  for (int r = 0; r < 16; ++r) p0[r] = (ABL & 2) ? fmaf(p0[r], p0[r], 1.f) : __builtin_amdgcn_exp2f(p0[r]); asm volatile("" : "+v"(p0), "+v"(p1)); }
template <int ABL> __device__ __forceinline__ void finishSM_nm(f32x16& p0, f32x16& p1, float& l_reg, bf16x8& pa0, bf16x8& pa1, bf16x8& pa2, bf16x8& pa3) {
  for (int r = 0; r < 16; ++r) p1[r] = (ABL & 2) ? fmaf(p1[r], p1[r], 1.f) : __builtin_amdgcn_exp2f(p1[r]);
  float ps = 0; for (int r = 0; r < 16; ++r) ps += p0[r]; for (int r = 0; r < 16; ++r) ps += p1[r];
  l_reg += ps; SBAR();
#define PK4(P, BASE, OUT) do { unsigned a0 = cvtpk(P[BASE + 0], P[BASE + 1]), a1 = cvtpk(P[BASE + 2], P[BASE + 3]);   \
    unsigned b0 = cvtpk(P[BASE + 4], P[BASE + 5]), b1 = cvtpk(P[BASE + 6], P[BASE + 7]);                              \
    auto r0 = __builtin_amdgcn_permlane32_swap(a0, b0, false, false); auto r1 = __builtin_amdgcn_permlane32_swap(a1, b1, false, false); \
    u32x4 w = {r0[0], r1[0], r0[1], r1[1]}; OUT = *reinterpret_cast<bf16x8*>(&w); } while (0)
  PK4(p0, 0, pa0); PK4(p0, 8, pa1); PK4(p1, 0, pa2); PK4(p1, 8, pa3);
#undef PK4
}
template <int ABL = 0> __device__ __forceinline__ void qkt(f32x16& p0, f32x16& p1, const bf16* Ks, const bf16x8* qr, int r32, int hi) {
  p0 = f32x16{}; p1 = f32x16{};
  for (int d0 = 0; d0 < 8; ++d0) { int cb = (((ABL & 16) ? 0 : d0) * 16 + hi * 8) * 2;
    bf16x8 b0, b1;
    if (ABL & 128) { b0 = qr[d0]; b1 = qr[d0 ^ 1]; } else {
    b0 = *reinterpret_cast<const bf16x8*>((const char*)Ks + KSWZ(r32, cb));
    b1 = *reinterpret_cast<const bf16x8*>((const char*)Ks + KSWZ(32 + r32, cb)); }
    if (ABL & 32) { asm volatile("" :: "v"(b0), "v"(b1)); continue; }
    p0 = __builtin_amdgcn_mfma_f32_32x32x16_bf16(b0, qr[d0], p0, 0, 0, 0);
    p1 = __builtin_amdgcn_mfma_f32_32x32x16_bf16(b1, qr[d0], p1, 0, 0, 0); }
}
template <int ABL = 0> __device__ __forceinline__ void qkt8(f32x16& p0, f32x16& p1, const char* Ks, const i32x8* qf, int r32, int hi, const f32x16& cinit) {
  const int g4 = ((r32 >> 1) & 7) << 4;
  if (ABL & 32) { p0 = cinit; p1 = cinit; }
#pragma unroll
  for (int s = 0; s < 2; ++s) { const int c0 = (s * 64 + hi * 32) ^ g4, c1 = (s * 64 + hi * 32 + 16) ^ g4;
    u32x4 a0, a1, b0, b1;
    if (ABL & 128) { a0 = u32x4{(unsigned)qf[0][0], (unsigned)qf[0][1], (unsigned)qf[1][2], (unsigned)qf[1][3]}; a1 = a0; b0 = a0; b1 = a0; } else {
    a0 = *reinterpret_cast<const u32x4*>(Ks + r32 * 128 + c0); a1 = *reinterpret_cast<const u32x4*>(Ks + r32 * 128 + c1);
    b0 = *reinterpret_cast<const u32x4*>(Ks + (32 + r32) * 128 + c0); b1 = *reinterpret_cast<const u32x4*>(Ks + (32 + r32) * 128 + c1); }
    const i32x8 A = {(int)a0.x, (int)a0.y, (int)a0.z, (int)a0.w, (int)a1.x, (int)a1.y, (int)a1.z, (int)a1.w};
    const i32x8 B = {(int)b0.x, (int)b0.y, (int)b0.z, (int)b0.w, (int)b1.x, (int)b1.y, (int)b1.z, (int)b1.w};
    if (ABL & 32) { asm volatile("" :: "v"(A), "v"(B)); continue; }
    if (s == 0) { p0 = __builtin_amdgcn_mfma_scale_f32_32x32x64_f8f6f4(A, qf[s], cinit, 0, 0, 0, 0, 0, 0); p1 = __builtin_amdgcn_mfma_scale_f32_32x32x64_f8f6f4(B, qf[s], cinit, 0, 0, 0, 0, 0, 0); }
    else { p0 = __builtin_amdgcn_mfma_scale_f32_32x32x64_f8f6f4(A, qf[s], p0, 0, 0, 0, 0, 0, 0); p1 = __builtin_amdgcn_mfma_scale_f32_32x32x64_f8f6f4(B, qf[s], p1, 0, 0, 0, 0, 0, 0); } }
}
template <int ABL = 0> __device__ __forceinline__ void finishSM_nm8(f32x16& p0, f32x16& p1, float& l_reg, i32x8& pf) {
  for (int r = 0; r < 16; ++r) p1[r] = (ABL & 2) ? fmaf(p1[r], p1[r], 1.f) : __builtin_amdgcn_exp2f(p1[r]);
  float ps = 0; for (int r = 0; r < 16; ++r) ps += p0[r]; for (int r = 0; r < 16; ++r) ps += p1[r];
  l_reg += ps; SBAR();
#pragma unroll
  for (int k = 0; k < 4; ++k) { int w = __builtin_amdgcn_cvt_pk_bf8_f32(p0[4 * k], p0[4 * k + 1], 0, false); w = __builtin_amdgcn_cvt_pk_bf8_f32(p0[4 * k + 2], p0[4 * k + 3], w, true); pf[k] = w;
    int v = __builtin_amdgcn_cvt_pk_bf8_f32(p1[4 * k], p1[4 * k + 1], 0, false); v = __builtin_amdgcn_cvt_pk_bf8_f32(p1[4 * k + 2], p1[4 * k + 3], v, true); pf[4 + k] = v; }
}
template <int DA> __device__ __forceinline__ void pv8_load2(i32x8* vf, const char* Vs, int r32, int hi) {
  const int g = ((r32 >> 2) & 3) << 4, c0 = (hi * 32) ^ g, c1 = (hi * 32 + 16) ^ g;
#pragma unroll
  for (int d0 = 0; d0 < 2; ++d0) { const char* rp = Vs + ((DA + d0) * 32 + r32) * 64;
    const u32x4 a0 = *reinterpret_cast<const u32x4*>(rp + c0), a1 = *reinterpret_cast<const u32x4*>(rp + c1);
    vf[d0] = i32x8{(int)a0.x, (int)a0.y, (int)a0.z, (int)a0.w, (int)a1.x, (int)a1.y, (int)a1.z, (int)a1.w}; }
}
template <int DA> __device__ __forceinline__ void pv8_mma2(f32x16* o, const i32x8* vf, const i32x8& pf) {
#pragma unroll
  for (int d0 = 0; d0 < 2; ++d0) o[DA + d0] = __builtin_amdgcn_mfma_scale_f32_32x32x64_f8f6f4(pf, vf[d0], o[DA + d0], 1, 0, 0, 0, 0, 0);
}
__device__ __forceinline__ void exp8(f32x16& p, int r0) {
#pragma unroll
  for (int r = 0; r < 8; ++r) p[r0 + r] = __builtin_amdgcn_exp2f(p[r0 + r]);
}
__device__ __forceinline__ void finish8a(f32x16& p0, f32x16& p1, i32x8& pf) {
#pragma unroll
  for (int r = 0; r < 16; ++r) p1[r] = __builtin_amdgcn_exp2f(p1[r]);
#pragma unroll
  for (int k = 0; k < 4; ++k) { int w = __builtin_amdgcn_cvt_pk_bf8_f32(p0[4 * k], p0[4 * k + 1], 0, false); w = __builtin_amdgcn_cvt_pk_bf8_f32(p0[4 * k + 2], p0[4 * k + 3], w, true); pf[k] = w;
    int v = __builtin_amdgcn_cvt_pk_bf8_f32(p1[4 * k], p1[4 * k + 1], 0, false); v = __builtin_amdgcn_cvt_pk_bf8_f32(p1[4 * k + 2], p1[4 * k + 3], v, true); pf[4 + k] = v; }
}
__device__ __forceinline__ void finish8b(const f32x16& p0, const f32x16& p1, float& l_reg) {
  float s0 = 0.f, s1 = 0.f;
#pragma unroll
  for (int r = 0; r < 16; ++r) { s0 += p0[r]; s1 += p1[r]; }
  l_reg += s0 + s1;
}
__device__ __forceinline__ void partial8(f32x16& p0) {
#pragma unroll
  for (int r = 0; r < 16; ++r) p0[r] = __builtin_amdgcn_exp2f(p0[r]);
}
template <int ABL = 0> __device__ __forceinline__ void pv8(f32x16* o, const char* Vs, const i32x8& pf, int r32, int hi) {
  const int g = ((r32 >> 2) & 3) << 4, c0 = (hi * 32) ^ g, c1 = (hi * 32 + 16) ^ g;
#pragma unroll
  for (int d0 = 0; d0 < 4; ++d0) { const char* rp = Vs + (d0 * 32 + r32) * 64;
    u32x4 a0, a1; if (ABL & 64) { a0 = u32x4{(unsigned)pf[0], (unsigned)pf[1], (unsigned)pf[2], (unsigned)pf[3]}; a1 = a0; } else { a0 = *reinterpret_cast<const u32x4*>(rp + c0); a1 = *reinterpret_cast<const u32x4*>(rp + c1); }
    const i32x8 Vf = {(int)a0.x, (int)a0.y, (int)a0.z, (int)a0.w, (int)a1.x, (int)a1.y, (int)a1.z, (int)a1.w};
    if (ABL & 1) { asm volatile("" :: "v"(Vf), "v"(pf)); continue; }
    o[d0] = __builtin_amdgcn_mfma_scale_f32_32x32x64_f8f6f4(pf, Vf, o[d0], 1, 0, 0, 0, 0, 0); }
}
__device__ __forceinline__ int v_st(int k, int c) { const int kk = (k & ~0xC) | ((k & 4) << 1) | ((k & 8) >> 1); return ((kk >> 3) * 4 + (c >> 5)) * 512 + ((kk & 7) * 32 + (c & 31)) * 2; }
__device__ __forceinline__ int v_rd_base(int lane) { return ((lane & 3) << 3) | (((lane >> 2) & 3) << 6) | (((lane >> 4) & 1) << 5) | (((lane >> 5) & 1) << 8); }
constexpr int v_rd_off(int d0, int ks, int half) { return d0 * 512 + ks * 4096 + half * 2048; }
template <int OFF> __device__ __forceinline__ s16x4 tr_read(int vb) {
  s16x4 r; asm volatile("ds_read_b64_tr_b16 %0, %1 offset:%2" : "=&v"(r) : "v"(vb), "i"(OFF) : "memory"); return r;
}
template <int D0, int ABL = 0> __device__ __forceinline__ void pv_one(f32x16& od, int vb, bf16x8 pa0, bf16x8 pa1, bf16x8 pa2, bf16x8 pa3) {
  if (ABL & 64) { const s16x4 z = {0, 0, 0, 0}; const bf16x8 zz = {z[0], z[1], z[2], z[3], z[0], z[1], z[2], z[3]}; if (!(ABL & 1)) { od = __builtin_amdgcn_mfma_f32_32x32x16_bf16(pa0, zz, od, 0, 0, 0); od = __builtin_amdgcn_mfma_f32_32x32x16_bf16(pa1, zz, od, 0, 0, 0); od = __builtin_amdgcn_mfma_f32_32x32x16_bf16(pa2, zz, od, 0, 0, 0); od = __builtin_amdgcn_mfma_f32_32x32x16_bf16(pa3, zz, od, 0, 0, 0); } return; }
  const s16x4 l0 = tr_read<v_rd_off(D0, 0, 0)>(vb), h0 = tr_read<v_rd_off(D0, 0, 1)>(vb), l1 = tr_read<v_rd_off(D0, 1, 0)>(vb), h1 = tr_read<v_rd_off(D0, 1, 1)>(vb);
  const s16x4 l2 = tr_read<v_rd_off(D0, 2, 0)>(vb), h2 = tr_read<v_rd_off(D0, 2, 1)>(vb), l3 = tr_read<v_rd_off(D0, 3, 0)>(vb), h3 = tr_read<v_rd_off(D0, 3, 1)>(vb);
  asm volatile("s_waitcnt lgkmcnt(0)" ::: "memory"); SBAR();
#define PK(L, H) (bf16x8){L[0], L[1], L[2], L[3], H[0], H[1], H[2], H[3]}
  if (ABL & 1) { asm volatile("" :: "v"(l0), "v"(h0), "v"(l1), "v"(h1), "v"(l2), "v"(h2), "v"(l3), "v"(h3), "v"(pa0), "v"(pa1), "v"(pa2), "v"(pa3)); return; }
  od = __builtin_amdgcn_mfma_f32_32x32x16_bf16(pa0, PK(l0, h0), od, 0, 0, 0);
  od = __builtin_amdgcn_mfma_f32_32x32x16_bf16(pa1, PK(l1, h1), od, 0, 0, 0);
  od = __builtin_amdgcn_mfma_f32_32x32x16_bf16(pa2, PK(l2, h2), od, 0, 0, 0);
  od = __builtin_amdgcn_mfma_f32_32x32x16_bf16(pa3, PK(l3, h3), od, 0, 0, 0);
#undef PK
}
template <int ABL = 0> __device__ __forceinline__ void pv_d0(f32x16* o, int vb, bf16x8 pa0, bf16x8 pa1, bf16x8 pa2, bf16x8 pa3) {
  pv_one<0, ABL>(o[0], vb, pa0, pa1, pa2, pa3); pv_one<1, ABL>(o[1], vb, pa0, pa1, pa2, pa3); pv_one<2, ABL>(o[2], vb, pa0, pa1, pa2, pa3); pv_one<3, ABL>(o[3], vb, pa0, pa1, pa2, pa3);
}

template <typename TQ, bool NOMAX, bool K8, int ABL = 0>
__device__ __forceinline__ bool attn_dense_body3(const TQ* __restrict__ Qb, const bf16* __restrict__ Kh, const bf16* __restrict__ Vh,
                                                bf16* __restrict__ Ob, int seq, char* lds, const float* __restrict__ qw, const float* __restrict__ rope, int tpos0) {
  using St = Stage<bf16>; using SQ = Stage<TQ>;
  int tid = threadIdx.x; asm volatile("" : "+v"(tid));
  const int wid = tid >> 6, lane = tid & 63, r32 = lane & 31, hi = lane >> 5;
  bf16* V_lds = (bf16*)lds; bf16* K_lds = (bf16*)(lds + 3 * SHM_V);
  float* ws = (float*)(lds + 3 * SHM_V + 3 * SHM_K) + wid * 64; float* li_l = ws; float* al_l = ws + 32;
  float m_reg = -1e30f, l_reg = 0; f32x16 o[4] = {}; bf16x8 qr[8]; i32x8 qf[2];
  const TQ* Qw = Qb + (long)(wid * QBLK + r32) * LDQ + hi * 8;
    const unsigned kl0 = (unsigned)(uintptr_t)K_lds + (unsigned)wid * 1024u, vl0 = (unsigned)(uintptr_t)V_lds + (unsigned)wid * 1024u;
#define DMA8(T, B) do { const long k0_ = (long)(T) * KVBLK * 256; int t_ = threadIdx.x; asm volatile("" : "+v"(t_)); \
      const unsigned ksrc8 = (unsigned)((t_ >> 3) * 256 + (((t_ & 7) ^ ((t_ >> 4) & 7)) << 4)), vsrc8 = (unsigned)((t_ >> 2) * 64 + (((t_ & 3) ^ ((t_ >> 4) & 3)) << 4));     \
      __builtin_amdgcn_global_load_lds((const unsigned*)((const char*)Kh + k0_ + ksrc8), (ATT_LAS unsigned*)(uintptr_t)(kl0 + (unsigned)(B) * (unsigned)SHM_K8), 16, 0, 0); \
      __builtin_amdgcn_global_load_lds((const unsigned*)((const char*)Vh + k0_ + vsrc8), (ATT_LAS unsigned*)(uintptr_t)(vl0 + (unsigned)(B) * (unsigned)SHM_V8), 16, 0, 0); } while (0)
  if constexpr (K8) { DMA8(0, 0); DMA8(1, 1); DMA8(2, 2); }
  {
    float xq[8][8]; float ssq = 0.f;
#pragma unroll
    for (int d0 = 0; d0 < 8; ++d0) { const bf16x8 raw = SQ::tobf(SQ::ld8(Qw + d0 * 16));
#pragma unroll
      for (int e = 0; e < 8; ++e) { const float v = __uint_as_float(((unsigned)(unsigned short)raw[e]) << 16); xq[d0][e] = v; ssq += v * v; } }
    { unsigned a0 = __float_as_uint(ssq), a1 = a0; asm volatile("" : "+v"(a1));
      auto rr = __builtin_amdgcn_permlane32_swap(a0, a1, false, false); ssq = __uint_as_float(rr[0]) + __uint_as_float(rr[1]); }
    const float rstd = rsqrtf(ssq * (1.f / 128.f) + 1e-6f);
    const int tq = tpos0 + wid * QBLK + r32;
    const float qcs = SCALE * 1.4426950408889634f;
#pragma unroll
    for (int d0 = 0; d0 < 8; ++d0) { const float4 w0 = *reinterpret_cast<const float4*>(qw + d0 * 16 + hi * 8), w1 = *reinterpret_cast<const float4*>(qw + d0 * 16 + hi * 8 + 4);
      xq[d0][0] *= rstd * w0.x; xq[d0][1] *= rstd * w0.y; xq[d0][2] *= rstd * w0.z; xq[d0][3] *= rstd * w0.w; xq[d0][4] *= rstd * w1.x; xq[d0][5] *= rstd * w1.y; xq[d0][6] *= rstd * w1.z; xq[d0][7] *= rstd * w1.w; }
#pragma unroll
    for (int gp = 0; gp < 4; ++gp) { const int dl = (gp & 1) + (gp >> 1) * 4, dh = dl + 2;
      const int pos = (gp >> 1) ? 128 + (tq & 63) : (tq >> 6);
      const float2* cs = reinterpret_cast<const float2*>(rope) + pos * 32 + (gp & 1) * 16 + hi * 8;
#pragma unroll
      for (int e = 0; e < 8; ++e) { const float2 c2 = cs[e]; const float x1 = xq[dl][e], x2 = xq[dh][e]; xq[dl][e] = (x1 * c2.x - x2 * c2.y) * qcs; xq[dh][e] = (x2 * c2.x + x1 * c2.y) * qcs; } }
#pragma unroll
    for (int d0 = 0; d0 < 8; ++d0) {
      if constexpr (K8) { int w0 = __builtin_amdgcn_cvt_pk_fp8_f32(xq[d0][0], xq[d0][1], 0, false); w0 = __builtin_amdgcn_cvt_pk_fp8_f32(xq[d0][2], xq[d0][3], w0, true);
        int w1 = __builtin_amdgcn_cvt_pk_fp8_f32(xq[d0][4], xq[d0][5], 0, false); w1 = __builtin_amdgcn_cvt_pk_fp8_f32(xq[d0][6], xq[d0][7], w1, true);
        qf[d0 >> 2][(d0 & 3) * 2] = w0; qf[d0 >> 2][(d0 & 3) * 2 + 1] = w1; }
      else { u32x4 w = {cvtpk(xq[d0][0], xq[d0][1]), cvtpk(xq[d0][2], xq[d0][3]), cvtpk(xq[d0][4], xq[d0][5]), cvtpk(xq[d0][6], xq[d0][7])}; qr[d0] = *reinterpret_cast<bf16x8*>(&w); } }
  }
  const int sr = tid >> 4, sc = (tid & 15) * 8, vst0 = v_st(sr, sc), vst1 = v_st(32 + sr, sc);
  const int vb0 = (int)(uintptr_t)V_lds + v_rd_base(lane);
  struct { typename St::T vs0, vs1, ks0, ks1; } sr_[SDEPTH];
  const int kr8 = tid >> 3, kc8 = (tid & 7) * 16;
  const int v8st = V8SWZ(tid >> 2, (tid & 3) * 16);
#define SLOAD(i, k0) do { if constexpr (K8) { sr_[i].vs0 = *reinterpret_cast<const bf16x8*>((const char*)Vh + (long)(k0) * 256 + tid * 16); \
      sr_[i].ks0 = *reinterpret_cast<const bf16x8*>((const char*)Kh + (long)((k0) + kr8) * 256 + kc8); } \
    else { sr_[i].vs0 = St::ld8(&Vh[(long)((k0) + sr) * LDK + sc]); sr_[i].vs1 = St::ld8(&Vh[(long)((k0) + 32 + sr) * LDK + sc]); \
      sr_[i].ks0 = St::ld8(&Kh[(long)((k0) + sr) * LDK + sc]); sr_[i].ks1 = St::ld8(&Kh[(long)((k0) + 32 + sr) * LDK + sc]); } } while (0)
#define SWRITE(b, i) do { if constexpr (K8) { *(bf16x8*)((char*)V_lds + (b) * SHM_V8 + v8st) = sr_[i].vs0; *(bf16x8*)((char*)K_lds + (b) * SHM_K8 + KSWZ8(kr8, kc8)) = sr_[i].ks0; } \
    else { *(bf16x8*)((char*)V_lds + (b) * SHM_V + vst0) = St::tobf(sr_[i].vs0);          \
    *(bf16x8*)((char*)V_lds + (b) * SHM_V + vst1) = St::tobf(sr_[i].vs1); int kc = sc * 2;               \
    *(bf16x8*)((char*)K_lds + (b) * SHM_K + KSWZ(sr, kc)) = St::tobf(sr_[i].ks0);                       \
    *(bf16x8*)((char*)K_lds + (b) * SHM_K + KSWZ(32 + sr, kc)) = St::tobf(sr_[i].ks1); } } while (0)
#define QKT(P0, P1, B) do { if constexpr (K8) qkt8<ABL>(P0, P1, (const char*)K_lds + (B) * SHM_K8, qf, r32, hi, cneg); else qkt<ABL>(P0, P1, (bf16*)((char*)K_lds + (B) * SHM_K), qr, r32, hi); } while (0)
#define PVT(B) do { if constexpr (K8) pv8<ABL>(o, (const char*)V_lds + (B) * SHM_V8, pf, r32, hi); else pv_d0<ABL>(o, vb0 + (B) * (int)SHM_V, pa0, pa1, pa2, pa3); } while (0)
#define SWAIT() do { if constexpr (SDEPTH == 2) asm volatile("s_waitcnt vmcnt(4)" ::: "memory"); else asm volatile("s_waitcnt vmcnt(0)" ::: "memory"); } while (0)
#define RESC(a) do { if (__any((a) < 1.f)) { if (hi == 0) al_l[r32] = (a); asm volatile("s_waitcnt lgkmcnt(0)" ::: "memory"); \
    for (int d = 0; d < 4; ++d) for (int r = 0; r < 16; ++r) o[d][r] *= al_l[crow(r, hi)]; } } while (0)
#define PSM(p0, p1, mn, al) do { if constexpr (NOMAX) partialSM_nm<ABL>(p0, p1); else partialSM(p0, p1, m_reg, mn, al); } while (0)
#define FSM(p0, p1, al) do { if constexpr (K8) finishSM_nm8<ABL>(p0, p1, l_reg, pf); else if constexpr (NOMAX) finishSM_nm<ABL>(p0, p1, l_reg, pa0, pa1, pa2, pa3); else finishSM(p0, p1, al, l_reg, pa0, pa1, pa2, pa3); } while (0)
#define RSC(al) do { if constexpr (!NOMAX) RESC(al); } while (0)
  f32x16 pA0, pA1, pB0, pB1; float mnA = 0.f, mnB = 0.f, alA = 1.f, alB = 1.f; bf16x8 pa0, pa1, pa2, pa3; i32x8 pf; f32x16 cneg = {}; const int NT = seq / KVBLK;
  constexpr int SE = 0, SO = SDEPTH - 1;
  if constexpr (K8) {
#define BARV(N) do { if (ABL & 4) asm volatile("s_waitcnt vmcnt(" N ") lgkmcnt(0)" ::: "memory"); else asm volatile("s_waitcnt vmcnt(" N ") lgkmcnt(0)\n\ts_barrier" ::: "memory"); } while (0)
    BARV("4");
    QKT(pA0, pA1, 0);
    {
    float m = pA0[0];
#pragma unroll
    for (int r = 1; r < 16; ++r) m = fmaxf(m, pA0[r]);
#pragma unroll
    for (int r = 0; r < 16; ++r) m = fmaxf(m, pA1[r]);
    { unsigned a0 = __float_as_uint(m), a1 = a0; asm volatile("" : "+v"(a1));
      auto rr = __builtin_amdgcn_permlane32_swap(a0, a1, false, false); m = fmaxf(__uint_as_float(rr[0]), __uint_as_float(rr[1])); }
#pragma unroll
    for (int r = 0; r < 16; ++r) { cneg[r] = -m; pA0[r] -= m; pA1[r] -= m; }
  }
    PSM(pA0, pA1, mnA, alA);
    BARV("2");
#define SG(m, n) __builtin_amdgcn_sched_group_barrier(m, n, 0)
#define SCHED_R1() do { if (ABL == 0) { SG(0x100, 4); SG(0x008, 2); SG(0x100, 4); SG(0x400, 4); SG(0x002, 6); SG(0x400, 4); SG(0x002, 6); SG(0x008, 1); SG(0x400, 4); SG(0x002, 6); SG(0x008, 1); SG(0x400, 4); SG(0x002, 6); } } while (0)
#define SCHED_H() do { if (ABL == 0) { SG(0x400, 8); SG(0x008, 1); SG(0x002, 8); SG(0x008, 1); SG(0x002, 8); } } while (0)
#define PV4(B, PN, PO0, PO1) do { i32x8 vfr[2]; \
      pv8_load2<0>(vfr, (const char*)V_lds + (B) * SHM_V8, r32, hi); SBAR(); exp8(PN, 0); pv8_mma2<0>(o, vfr, pf); _Pragma("unroll") for (int r_ = 0; r_ < 16; ++r_) l_reg += PO0[r_]; SCHED_H(); SBAR(); \
      pv8_load2<2>(vfr, (const char*)V_lds + (B) * SHM_V8, r32, hi); SBAR(); exp8(PN, 8); pv8_mma2<2>(o, vfr, pf); _Pragma("unroll") for (int r_ = 0; r_ < 16; ++r_) l_reg += PO1[r_]; SCHED_H(); } while (0)
    for (int j = 1; j + 1 < NT; j += 2) {
      SBAR(); QKT(pB0, pB1, j & 3); finish8a(pA0, pA1, pf); SCHED_R1(); SBAR();
      if (!(ABL & 8)) DMA8(j + 2, (j + 2) & 3); SBAR();
      PV4((j - 1) & 3, pB0, pA0, pA1);
      BARV("2");
      SBAR(); QKT(pA0, pA1, (j + 1) & 3); finish8a(pB0, pB1, pf); SCHED_R1(); SBAR();
      if (!(ABL & 8) && j + 3 < NT) DMA8(j + 3, (j + 3) & 3); SBAR();
      PV4(j & 3, pA0, pB0, pB1);
      if (j + 3 < NT) BARV("2"); else BARV("0");
    }
    __builtin_amdgcn_s_setprio(0);
#undef SCHED_R1
#undef SCHED_H
#undef PV4
#undef SG
    SBAR(); QKT(pB0, pB1, (NT - 1) & 3);
    FSM(pA0, pA1, alA); SBAR();
    PVT((NT - 2) & 3); PSM(pB0, pB1, mnB, alB);
    FSM(pB0, pB1, alB); SBAR();
    PVT((NT - 1) & 3);
#undef BARV
#undef DMA8
  } else {
  SLOAD(SE, 0); asm volatile("s_waitcnt vmcnt(0)" ::: "memory"); SWRITE(0, SE); __syncthreads();
  QKT(pA0, pA1, 0);
  PSM(pA0, pA1, mnA, alA);
  SLOAD(SO, KVBLK); if constexpr (SDEPTH == 2) { if (2 < NT) SLOAD(SE, 2 * KVBLK); }
  SWAIT(); SWRITE(1, SO); __syncthreads();
  int bk = 1, bv = 0, bw = 2;
#define ROT3() do { const int _t = bv; bv = bk; bk = bw; bw = _t; } while (0)
  for (int j = 1; j + 1 < NT; j += 2) {
    SBAR(); QKT(pB0, pB1, bk);
    FSM(pA0, pA1, alA); SBAR();
    if (!(ABL & 8)) SLOAD(SO, (j + SDEPTH) * KVBLK); SBAR();
    PVT(bv); PSM(pB0, pB1, mnB, alB);
    if (!(ABL & 8)) { SWAIT(); SWRITE(bw, SE); }
    RSC(alB); if (!(ABL & 4)) __syncthreads();
    ROT3();
    SBAR(); QKT(pA0, pA1, bk);
    FSM(pB0, pB1, alB); SBAR();
    if (!(ABL & 8) && (SDEPTH == 1 || j + 3 < NT)) SLOAD(SE, (j + 1 + SDEPTH) * KVBLK); SBAR();
    PVT(bv); PSM(pA0, pA1, mnA, alA);
    if (!(ABL & 8)) { SWAIT(); SWRITE(bw, SO); }
    RSC(alA); if (!(ABL & 4)) __syncthreads();
    ROT3();
  }
  SBAR(); QKT(pB0, pB1, bk);
  FSM(pA0, pA1, alA); SBAR();
  PVT(bv); PSM(pB0, pB1, mnB, alB);
  __syncthreads(); RSC(alB);
  FSM(pB0, pB1, alB); SBAR();
  PVT(bk);
#undef ROT3
  }
  if constexpr (NOMAX) { auto rr = __builtin_amdgcn_permlane32_swap(__float_as_uint(l_reg), __float_as_uint(l_reg), false, false); l_reg = __uint_as_float(rr[0]) + __uint_as_float(rr[1]); }
  if constexpr (K8) {
    int* bad_l = (int*)(lds + 3 * SHM_V + 3 * SHM_K + NW * 64 * 4);
    const int bad = (ABL == 0 && __any(!(l_reg < 5.0e4f))) ? 1 : 0; if (lane == 0) bad_l[wid] = bad; }
  if (hi == 0) li_l[r32] = l_reg; asm volatile("s_waitcnt lgkmcnt(0)" ::: "memory");
  float rli[16];
#pragma unroll
  for (int r = 0; r < 16; ++r) rli[r] = __builtin_amdgcn_rcpf(li_l[crow(r, hi)]);
  __syncthreads();
  if constexpr (K8) { const int* bad_l = (const int*)(lds + 3 * SHM_V + 3 * SHM_K + NW * 64 * 4); int anyb = 0;
#pragma unroll
    for (int w = 0; w < NW; ++w) anyb |= bad_l[w];
    if (__builtin_amdgcn_readfirstlane(anyb)) return false; }
  bf16* Os = (bf16*)(lds + wid * 8192);
#pragma unroll
  for (int r = 0; r < 16; ++r) { const int orow = crow(r, hi);
#pragma unroll
    for (int d0 = 0; d0 < 4; ++d0) Os[orow * 128 + d0 * 32 + r32] = (bf16)(cvtpk(o[d0][r] * rli[r], 0.f) & 0xffffu); }
  int tide = threadIdx.x; asm volatile("" : "+v"(tide));
  bf16* Ow = Ob + (long)((tide >> 6) * QBLK) * LDO;
#pragma unroll
  for (int k = 0; k < 8; ++k) { const int ci = k * 64 + (tide & 63), row = ci >> 4, c16 = ci & 15;
    const u32x4 v = *reinterpret_cast<const u32x4*>(Os + row * 128 + c16 * 8);
    *reinterpret_cast<u32x4*>(Ow + (long)row * LDO + c16 * 8) = v; }
#undef SLOAD
#undef SWRITE
#undef QKT
#undef PVT
#undef SWAIT
#undef RESC
#undef PSM
#undef FSM
#undef RSC
  return true;
}


#undef KSWZ
#undef KSWZ8
#undef V8SWZ
#undef SBAR
}

#define GAS __attribute__((address_space(1)))
#define LAS __attribute__((address_space(3)))
typedef unsigned v4u __attribute__((ext_vector_type(4)));
typedef float f32x4 __attribute__((ext_vector_type(4)));
typedef short bf16x8 __attribute__((ext_vector_type(8)));
typedef GAS unsigned gu32;
typedef GAS unsigned long long gu64;
#define RLX_AGENT __ATOMIC_RELAXED, __HIP_MEMORY_SCOPE_AGENT
#define LDS_WAIT() asm volatile("s_waitcnt lgkmcnt(0)" ::: "memory")
#define VM_WAIT() asm volatile("s_waitcnt vmcnt(0)" ::: "memory")
__device__ __forceinline__ unsigned long long rt() { return __builtin_amdgcn_s_memrealtime(); }
__device__ __forceinline__ unsigned f2bf(float f) { unsigned u = __builtin_bit_cast(unsigned, f); return (u + 0x7fffu + ((u >> 16) & 1u)) >> 16; }
__device__ __forceinline__ unsigned pk2(float lo, float hi) { return f2bf(lo) | (f2bf(hi) << 16); }

#define XB_TMO      128
#define XB_XCNT(j)  (256  + 64 * (j))
#define XB_XSUB(j)  (1280 + 64 * (j))
#define XB_XGEN(j)  (2304 + 64 * (j))
#define XB_TOP      3328
#define XB_TOPGEN   3392
#define XCD_BAR_WORDS 3456
#define XB_SPIN_CAP (1u << 18)

__device__ __forceinline__ unsigned xb_ld(unsigned* p)              { return __hip_atomic_load(p, __ATOMIC_RELAXED, __HIP_MEMORY_SCOPE_AGENT); }
__device__ __forceinline__ unsigned xb_add(unsigned* p, unsigned v) { return __hip_atomic_fetch_add(p, v, __ATOMIC_RELAXED, __HIP_MEMORY_SCOPE_AGENT); }
__device__ __forceinline__ unsigned xb_xcc_id() { return (unsigned)__builtin_amdgcn_s_getreg((3 << 11) | 20) & 0xFu; }
#define XB_SPIN(cond, bar) do { unsigned _sp = 0; while (cond) { __builtin_amdgcn_s_sleep(1); \
    if ((++_sp & 255u) == 0u) { if (xb_ld(&(bar)[XB_TMO])) break; if (_sp > XB_SPIN_CAP) { atomicAdd(&(bar)[XB_TMO], 1u); break; } } } } while (0)

struct XcdBarrier {
    unsigned* bar; unsigned x;
    volatile LAS unsigned* st;
};

__device__ __forceinline__ XcdBarrier xcd_barrier_post(unsigned* bar, volatile LAS unsigned* st) {
    XcdBarrier b; b.bar = bar; b.x = xb_xcc_id(); b.st = st;
    if (threadIdx.x == 0) (void)xb_add(&bar[XB_XCNT(b.x)], 1u);
    return b;
}
__device__ __forceinline__ void xcd_barrier_complete(unsigned* bar, unsigned x, unsigned& nloc, unsigned& nx) {
    const unsigned G = gridDim.x * gridDim.y * gridDim.z;
    unsigned sum, cnt, mine, sp = 0u;
    for (;;) {
        sum = 0u; cnt = 0u; mine = 0u;
#pragma unroll
        for (unsigned j = 0; j < 16; ++j) { const unsigned c = xb_ld(&bar[XB_XCNT(j)]); sum += c; cnt += (c > 0u) ? 1u : 0u; mine = (j == x) ? c : mine; }
        if (sum == G) break;
        __builtin_amdgcn_s_sleep(1);
        if ((++sp & 255u) == 0u) { if (xb_ld(&bar[XB_TMO])) break; if (sp > XB_SPIN_CAP) { atomicAdd(&bar[XB_TMO], 1u); break; } }
    }
    nloc = mine > 0u ? mine : 1u; nx = cnt > 0u ? cnt : 1u;
}

__device__ __forceinline__ void xcd_barrier(const XcdBarrier& b) {
    asm volatile("s_waitcnt vmcnt(0)" ::: "memory");
    __syncthreads();
    if (threadIdx.x == 0) {
        unsigned* bar = b.bar;
        __builtin_amdgcn_s_waitcnt(0);
        unsigned nloc = b.st[0], nx = b.st[1];
        if (nloc == 0u) { xcd_barrier_complete(bar, b.x, nloc, nx); b.st[0] = nloc; b.st[1] = nx; }
        const unsigned old = xb_add(&bar[XB_XSUB(b.x)], 1u);
        const unsigned gen = old / nloc;
        if (old + 1u == (gen + 1u) * nloc) {
            __builtin_amdgcn_fence(__ATOMIC_RELEASE, "agent");
            asm volatile("s_waitcnt vmcnt(0)" ::: "memory");
            const unsigned og = xb_add(&bar[XB_TOP], 1u);
            const unsigned tg = og / nx;
            if (og + 1u == (tg + 1u) * nx) xb_add(&bar[XB_TOPGEN], 1u);
            else XB_SPIN(xb_ld(&bar[XB_TOPGEN]) == tg, bar);
            __builtin_amdgcn_fence(__ATOMIC_ACQUIRE, "agent");
            xb_add(&bar[XB_XGEN(b.x)], 1u);
            asm volatile("s_waitcnt vmcnt(0)" ::: "memory");
        } else {
            XB_SPIN(xb_ld(&bar[XB_XGEN(b.x)]) == gen, bar);
            __builtin_amdgcn_fence(__ATOMIC_ACQUIRE, "agent");
            asm volatile("s_waitcnt vmcnt(0)" ::: "memory");
        }
    }
    __syncthreads();
}

typedef unsigned short bf16;
typedef float f32x2 __attribute__((ext_vector_type(2)));
typedef float f32x16 __attribute__((ext_vector_type(16)));
typedef __bf16 bf16x2_t __attribute__((ext_vector_type(2)));
constexpr int NWAVES = 8, NTHR = 512;
constexpr int LDS_BYTES = 147456, LDSCTL_OFF = LDS_BYTES - 256;
constexpr int CW_CMAXQ = 16384;
constexpr int CW_CMAX = 8192;
constexpr int CW_VF = 96;
constexpr int CW_BAR = 1024;
static_assert((CW_BAR + XCD_BAR_WORDS) * 4 <= (int)CTL_ZERO_BYTES, "control words inside the memset region");

struct Args {
    const float *x, *c, *ada_w, *ada_b, *norm_mix_w, *w_in, *q_norm_w, *k_norm_w, *w_attn_o, *pool_mix_w, *pool_scale, *w_pool_o, *w_out, *norm_ffn_w,
                *w_query, *sub_keys, *expert_u, *expert_v, *final_norm_w;
    float* out; unsigned char* ws; int ph_lo, ph_hi;
};

__device__ __forceinline__ unsigned pkbf(float lo, float hi) { return pg8::cvt_pk_bf16(lo, hi); }
__device__ __forceinline__ float bflo(unsigned w) { return __builtin_bit_cast(float, w << 16); }
__device__ __forceinline__ float bfhi(unsigned w) { return __builtin_bit_cast(float, w & 0xffff0000u); }
template <int M> __device__ __forceinline__ int shx_i(int x, bool upper) {
    if constexpr (M == 1) return __builtin_amdgcn_update_dpp(0, x, 0xB1, 0xF, 0xF, false);
    else if constexpr (M == 2) return __builtin_amdgcn_update_dpp(0, x, 0x4E, 0xF, 0xF, false);
    else if constexpr (M == 8) return __builtin_amdgcn_update_dpp(0, x, 0x128, 0xF, 0xF, false);
    else if constexpr (M == 4 || M == 16) return __builtin_amdgcn_ds_swizzle(x, (M << 10) | 0x1F);
    else { static_assert(M == 32, "shx: 1, 2, 4, 8, 16 or 32"); int y = x; asm volatile("" : "+v"(y));
        const auto rr = __builtin_amdgcn_permlane32_swap((unsigned)x, (unsigned)y, false, false); return (int)(upper ? rr[0] : rr[1]); }
}
__device__ __forceinline__ float shx_hm(float v) { return __builtin_bit_cast(float, __builtin_amdgcn_update_dpp(0, __builtin_bit_cast(int, v), 0x141, 0xF, 0xF, false)); }
__device__ __forceinline__ float shx16p(float v, bool odd16) { int x = __builtin_bit_cast(int, v), y = x; asm volatile("" : "+v"(y));
    const auto rr = __builtin_amdgcn_permlane16_swap((unsigned)x, (unsigned)y, false, false); return __builtin_bit_cast(float, (int)(odd16 ? rr[0] : rr[1])); }
template <int M> __device__ __forceinline__ float shx(float v, bool upper = false) { return __builtin_bit_cast(float, shx_i<M>(__builtin_bit_cast(int, v), upper)); }
__device__ __forceinline__ float wave_sum(float v) {
    v += shx<1>(v); v += shx<2>(v); v += shx<4>(v); v += shx<8>(v); v += shx<16>(v);
    return __builtin_bit_cast(float, __builtin_amdgcn_readlane(__builtin_bit_cast(int, v), 0)) + __builtin_bit_cast(float, __builtin_amdgcn_readlane(__builtin_bit_cast(int, v), 32));
}
__device__ __forceinline__ float wave_max(float v) {
    v = fmaxf(v, shx<1>(v)); v = fmaxf(v, shx<2>(v)); v = fmaxf(v, shx<4>(v)); v = fmaxf(v, shx<8>(v)); v = fmaxf(v, shx<16>(v));
    return fmaxf(__builtin_bit_cast(float, __builtin_amdgcn_readlane(__builtin_bit_cast(int, v), 0)), __builtin_bit_cast(float, __builtin_amdgcn_readlane(__builtin_bit_cast(int, v), 32)));
}
__device__ __forceinline__ unsigned q8x4(float a, float b, float c, float d, float inv) {
    const int ia = (int)rintf(fminf(fmaxf(a * inv, -127.f), 127.f)), ib = (int)rintf(fminf(fmaxf(b * inv, -127.f), 127.f)), ic = (int)rintf(fminf(fmaxf(c * inv, -127.f), 127.f)), id = (int)rintf(fminf(fmaxf(d * inv, -127.f), 127.f));
    return (unsigned)(ia & 255) | ((unsigned)(ib & 255) << 8) | ((unsigned)(ic & 255) << 16) | ((unsigned)(id & 255) << 24);
}
__device__ __forceinline__ float dot2bf(unsigned a, unsigned b, float acc) { return __builtin_amdgcn_fdot2_f32_bf16(__builtin_bit_cast(bf16x2_t, a), __builtin_bit_cast(bf16x2_t, b), acc, false); }

__device__ __forceinline__ void p0_wmax_item(const float* W, unsigned* CMAX, int item, int lane) {
    const int cg = item >> 4, kc = item & 15, n = cg * 64 + lane; const float* wp = W + (size_t)(kc * 64) * 4096 + n;
    float am = 0.f;
#pragma unroll 16
    for (int k = 0; k < 64; ++k) am = fmaxf(am, fabsf(wp[(size_t)k * 4096]));
    atomicMax(CMAX + n, __builtin_bit_cast(unsigned, am));
}
__device__ __forceinline__ void win8_item(const float* W, const unsigned* CMAX, unsigned char* WT8, float* SW, int item, int lane) {
    const int cg = item >> 4, kc = item & 15, n = cg * 64 + lane; const float* wp = W + (size_t)(kc * 64) * 4096 + n;
    const float am = __builtin_bit_cast(float, __hip_atomic_load(CMAX + n, __ATOMIC_RELAXED, __HIP_MEMORY_SCOPE_AGENT));
    const float sw = (am > 0.f) ? am * (1.f / 127.f) : 1.f, inv = 1.f / sw;
    if (kc == 0) SW[n] = sw;
#pragma unroll
    for (int k0 = 0; k0 < 64; k0 += 16) { float v[16];
#pragma unroll
        for (int j = 0; j < 16; ++j) v[j] = wp[(size_t)(k0 + j) * 4096];
        v4u o; o.x = q8x4(v[0], v[1], v[2], v[3], inv); o.y = q8x4(v[4], v[5], v[6], v[7], inv); o.z = q8x4(v[8], v[9], v[10], v[11], inv); o.w = q8x4(v[12], v[13], v[14], v[15], inv);
        *(v4u*)(WT8 + (size_t)n * 1024 + kc * 64 + k0) = o; }
}
__device__ __forceinline__ void p0_transpose_item(const float* W, int K, int N, bf16* WT, LAS float* scr, int item, int lane) {
    const int nblk = N / 32, kb = item / nblk, nb = item % nblk, k0 = 64 * kb, n0 = 32 * nb;
#pragma unroll 8
    for (int i = 0; i < 32; ++i) { const int kk = 2 * i + (lane >> 5); scr[kk * 33 + (lane & 31)] = W[(size_t)(k0 + kk) * N + n0 + (lane & 31)]; }
    LDS_WAIT(); asm volatile("" ::: "memory");
    const int c = lane & 7;
#pragma unroll
    for (int j = 0; j < 4; ++j) { const int n = (lane >> 3) + 8 * j; const LAS float* s = scr + (8 * c) * 33 + n;
        v4u o; o.x = pkbf(s[0 * 33], s[1 * 33]); o.y = pkbf(s[2 * 33], s[3 * 33]); o.z = pkbf(s[4 * 33], s[5 * 33]); o.w = pkbf(s[6 * 33], s[7 * 33]);
        *(v4u*)(WT + (size_t)(n0 + n) * K + k0 + 8 * c) = o; }
    LDS_WAIT(); asm volatile("" ::: "memory");
}
__device__ __forceinline__ void cvt8_range(const float* src, bf16* dst, size_t n8, int gt, int NGT) {
    for (size_t i = gt; i < n8; i += NGT) {
        const f32x4 a = *(const f32x4*)(src + i * 8), b = *(const f32x4*)(src + i * 8 + 4);
        v4u o; o.x = pkbf(a[0], a[1]); o.y = pkbf(a[2], a[3]); o.z = pkbf(b[0], b[1]); o.w = pkbf(b[2], b[3]);
        *(v4u*)(dst + i * 8) = o;
    }
}
__device__ __forceinline__ void p0_prologue(const Args& a, LAS unsigned char* lds, int tid, int lane, int wave, int bid, int G, int part  ) {
    unsigned char* ws = a.ws;
    const int gw = bid * NWAVES + wave, NGW = G * NWAVES, gt = bid * NTHR + tid, NGT = G * NTHR;
    if (part == 0) {
        LAS float* cs = (LAS float*)lds;
        LAS float* red = (LAS float*)(lds + 16384);
        float* MOD = (float*)(ws + WS_MOD);
        if (bid < 192 || G < 192) {
            for (int k = tid; k < 1024; k += NTHR)
#pragma unroll
                for (int b = 0; b < 4; ++b) { const float v = a.c[b * 1024 + k]; cs[k * 4 + b] = v / (1.f + __expf(-v)); }
            __syncthreads();
            for (int bt = bid; bt < 192; bt += G) {
                const int l = bt / 96, n0 = (bt % 96) * 64;
                const float* wp = a.ada_w + ((size_t)l * 1024 + wave * 128) * 6144 + n0 + lane;
                float acc0 = 0.f, acc1 = 0.f, acc2 = 0.f, acc3 = 0.f;
#pragma unroll 16
                for (int kk = 0; kk < 128; ++kk) {
                    const float wv = wp[(size_t)kk * 6144];
                    const f32x4 c4 = *(const LAS f32x4*)(cs + (wave * 128 + kk) * 4);
                    acc0 += c4[0] * wv; acc1 += c4[1] * wv; acc2 += c4[2] * wv; acc3 += c4[3] * wv;
                }
                red[(wave * 4 + 0) * 64 + lane] = acc0; red[(wave * 4 + 1) * 64 + lane] = acc1; red[(wave * 4 + 2) * 64 + lane] = acc2; red[(wave * 4 + 3) * 64 + lane] = acc3;
                __syncthreads();
                if (tid < 256) { const int b = tid >> 6; float s = a.ada_b[l * 6144 + n0 + lane];
#pragma unroll
                    for (int w = 0; w < 8; ++w) s += red[(w * 4 + b) * 64 + lane];
                    MOD[(size_t)(l * 4 + b) * 6144 + n0 + lane] = s; }
                __syncthreads();
            }
        }
        __syncthreads();
    }
    if (part == 0) return;
    {
        f32x2* RT = (f32x2*)(ws + WS_ROPE);
        for (int idx = gt; idx < 192 * 32; idx += NGT) {
            const int pos = idx >> 5, i = idx & 31; const float pv = (float)(pos < 128 ? pos : pos - 128);
            const float inv = exp2f(-(float)i * (13.287712379549449f / 32.f));
            const float ang = pv * inv;
            f32x2 cs2; cs2.x = __cosf(ang); cs2.y = __sinf(ang); RT[idx] = cs2;
        }
    }
    {
        LAS float* scr = (LAS float*)(lds + wave * 16384);
        constexpr int I_IN = 1024, I_AO = 16 * 32, I_OUT = 16 * 32, I_L = I_AO + I_OUT;
        for (int it = gw; it < 2 * I_IN + 2 * I_L; it += NGW) {
            if (it < 2 * I_IN) { const int l = it / I_IN, r = it % I_IN; p0_wmax_item(a.w_in + (size_t)l * 1024 * 4096, (unsigned*)(ws + WS_CTL) + CW_CMAX + l * 4096, r, lane); continue; }
            const int l = (it - 2 * I_IN) / I_L; int r = (it - 2 * I_IN) % I_L;
            if (r < I_AO) { p0_transpose_item(a.w_attn_o + (size_t)l * 1024 * 1024, 1024, 1024, (bf16*)(ws + WS_WAO) + (size_t)l * 1024 * 1024, scr, r, lane); continue; } r -= I_AO;
            p0_transpose_item(a.w_out + (size_t)l * 1024 * 1024, 1024, 1024, (bf16*)(ws + WS_WOUT) + (size_t)l * 1024 * 1024, scr, r, lane);
        }
    }
    {
        bf16* W2 = (bf16*)(ws + WS_WPO);
        for (int it = gw; it < 2 * 4 * 16 * 16; it += NGW) {
            const int l = it >> 10, g = (it >> 8) & 3, cc = (it >> 4) & 15, nb = it & 15, n = nb * 64 + lane;
            const float* mp = a.pool_mix_w + ((size_t)(l * 4 + g) * 128 + cc * 8) * 128;
            const float* sp = a.pool_scale + l * 512 + g * 128;
            const float* wp = a.w_pool_o + ((size_t)l * 512 + g * 128) * 1024 + n;
            float acc[8] = {0.f, 0.f, 0.f, 0.f, 0.f, 0.f, 0.f, 0.f};
#pragma unroll 8
            for (int d = 0; d < 128; ++d) { const float wv = wp[(size_t)d * 1024] * sp[d];
#pragma unroll
                for (int i = 0; i < 8; ++i) acc[i] += mp[i * 128 + d] * wv; }
            v4u o; o.x = pkbf(acc[0], acc[1]); o.y = pkbf(acc[2], acc[3]); o.z = pkbf(acc[4], acc[5]); o.w = pkbf(acc[6], acc[7]);
            *(v4u*)(W2 + ((size_t)l * 1024 + n) * 512 + g * 128 + cc * 8) = o;
        }
    }
    cvt8_range(a.w_query, (bf16*)(ws + WS_WQB), (size_t)2 * 1024 * 4096 / 8, gt, NGT);
    {
        bf16* AB = (bf16*)(ws + WS_ABD);
        for (int i = gt; i < 2 * 2048 * 64; i += NGT) {
            const int l = i / (2048 * 64), r = i % (2048 * 64), n = r >> 6, kc = (n >> 8) * 64 + (r & 63), hp = n >> 7;
            v4u o = {0u, 0u, 0u, 0u};
            if ((kc >> 5) == hp) { const float* p = a.sub_keys + ((size_t)(l * 16 + hp) * 128 + (n & 127)) * 256 + (kc & 31) * 8;
                const f32x4 u0 = *(const f32x4*)p, u1 = *(const f32x4*)(p + 4); o.x = pkbf(u0[0], u0[1]); o.y = pkbf(u0[2], u0[3]); o.z = pkbf(u1[0], u1[1]); o.w = pkbf(u1[2], u1[3]); }
            *(v4u*)(AB + ((size_t)l * 2048 + n) * 4096 + kc * 8) = o;
        }
    }
}

template <bool XBF = false  >
__device__ __forceinline__ void normmod_phase(const float* X, const float* w, const float* modl, int sh_off, int sc_off, bf16* XN, int gw, int NGW, int lane, unsigned* XQ = nullptr, float* SX = nullptr) {
    const int per = (TOK + NGW - 1) / NGW, r0 = gw * per, r1 = (r0 + per < TOK) ? r0 + per : TOK;
    int curb = -1; f32x4 A[4], Bv[4];
    for (int rb = r0; rb < r1; rb += 4) {
        const int b = rb >> 13;
        if (b != curb) { curb = b;
#pragma unroll
            for (int j = 0; j < 4; ++j) { const f32x4 wv = *(const f32x4*)(w + 4 * lane + 256 * j); const f32x4 sc = *(const f32x4*)(modl + (size_t)b * 6144 + sc_off + 4 * lane + 256 * j);
                A[j] = wv * (sc + 1.0f); Bv[j] = *(const f32x4*)(modl + (size_t)b * 6144 + sh_off + 4 * lane + 256 * j); } }
        f32x4 v[4][4]; float ss[4];
#pragma unroll
        for (int q = 0; q < 4; ++q) { const int r = (rb + q < r1) ? rb + q : r1 - 1; ss[q] = 0.f;
#pragma unroll
            for (int j = 0; j < 4; ++j) {
                if (XBF) { const unsigned long long raw = *(const unsigned long long*)((const bf16*)X + (size_t)r * 2048 + 1024 + 4 * lane + 256 * j); const unsigned lo = (unsigned)raw, hi = (unsigned)(raw >> 32);
                    v[q][j] = f32x4{bflo(lo), bfhi(lo), bflo(hi), bfhi(hi)}; }
                else v[q][j] = *(const f32x4*)(X + (size_t)r * 1024 + 4 * lane + 256 * j); } }
#pragma unroll
        for (int q = 0; q < 4; ++q)
#pragma unroll
            for (int j = 0; j < 4; ++j) ss[q] += (v[q][j][0] * v[q][j][0] + v[q][j][1] * v[q][j][1]) + (v[q][j][2] * v[q][j][2] + v[q][j][3] * v[q][j][3]);
#pragma unroll
        for (int q = 0; q < 4; ++q) { const int r = rb + q; if (r >= r1) break;
            const float rstd = rsqrtf(wave_sum(ss[q]) * (1.f / 1024.f) + EPS);
#pragma unroll
            for (int j = 0; j < 4; ++j) { const f32x4 y = v[q][j] * rstd * A[j] + Bv[j]; v[q][j] = y;
                f32x2 o; ((unsigned*)&o)[0] = pkbf(y[0], y[1]); ((unsigned*)&o)[1] = pkbf(y[2], y[3]);
                if (XN) *(f32x2*)(XN + (size_t)r * 1024 + 4 * lane + 256 * j) = o; }
            if (XQ) { float am = 0.f;
#pragma unroll
                for (int j = 0; j < 4; ++j) am = fmaxf(fmaxf(am, fmaxf(fabsf(v[q][j][0]), fabsf(v[q][j][1]))), fmaxf(fabsf(v[q][j][2]), fabsf(v[q][j][3])));
                am = wave_max(am); const float sx = (am > 0.f) ? am * (1.f / 127.f) : 1.f, inv = 1.f / sx;
#pragma unroll
                for (int j = 0; j < 4; ++j) XQ[(size_t)r * 256 + lane + 64 * j] = q8x4(v[q][j][0], v[q][j][1], v[q][j][2], v[q][j][3], inv);
                if (lane == 0) SX[r] = sx; } }
    }
}

__device__ __forceinline__ void qknorm_rope_phase(bf16* Q, bf16* K, unsigned char* K8, const float* qw, const float* kw, const f32x2* RT, int gw, int NGW, int lane, size_t probe_off = 0  ) {
    const int sub = lane & 15, grp = lane >> 4;
    for (int i = gw; i < TOK * 2 / 4; i += NGW) {
        const int it = i * 4 + grp, t = it >> 1, hd = 8 + (it & 1);
        bf16* p = (hd < 8) ? (Q + (size_t)t * 1024 + hd * 128 + sub * 8) : (K + (size_t)t * 256 + (hd - 8) * 128 + sub * 8);
        const float* wn = ((hd < 8) ? qw : kw) + sub * 8;
        const v4u raw = *(const v4u*)p;
        float x[8] = {bflo(raw.x), bfhi(raw.x), bflo(raw.y), bfhi(raw.y), bflo(raw.z), bfhi(raw.z), bflo(raw.w), bfhi(raw.w)};
        float ss = 0.f;
#pragma unroll
        for (int e = 0; e < 8; ++e) ss += x[e] * x[e];
        ss += shx<1>(ss); ss += shx<2>(ss); ss += shx<4>(ss); ss += shx<8>(ss);
        const float rstd = rsqrtf(ss * (1.f / 128.f) + EPS);
        const f32x4 w0 = *(const f32x4*)wn, w1 = *(const f32x4*)(wn + 4);
        float y[8];
#pragma unroll
        for (int e = 0; e < 8; ++e) y[e] = x[e] * rstd * (e < 4 ? w0[e] : w1[e - 4]);
        const int tl = t & (SEQ - 1), pos = (sub & 8) ? (128 + (tl & 63)) : (tl >> 6);
        const f32x2* rt = RT + pos * 32 + (sub & 3) * 8;
        const float sgn = (sub & 4) ? 1.f : -1.f;
        float o[8];
        const float qc = (hd < 8) ? 0.088388347648318440f * 1.4426950408889634f : 1.f;
#pragma unroll
        for (int e = 0; e < 8; ++e) { const float pr = shx<4>(y[e]); const f32x2 cs2 = rt[e]; o[e] = (y[e] * cs2.x + sgn * pr * cs2.y) * qc; }
        v4u ov; ov.x = pkbf(o[0], o[1]); ov.y = pkbf(o[2], o[3]); ov.z = pkbf(o[4], o[5]); ov.w = pkbf(o[6], o[7]);
        *(v4u*)(p + probe_off) = ov;
        if (K8 != nullptr && probe_off == 0) { int w0 = __builtin_amdgcn_cvt_pk_fp8_f32(o[0], o[1], 0, false); w0 = __builtin_amdgcn_cvt_pk_fp8_f32(o[2], o[3], w0, true);
            int w1 = __builtin_amdgcn_cvt_pk_fp8_f32(o[4], o[5], 0, false); w1 = __builtin_amdgcn_cvt_pk_fp8_f32(o[6], o[7], w1, true);
            uint2 wv; wv.x = (unsigned)w0; wv.y = (unsigned)w1;
            *(uint2*)(K8 + (size_t)t * 256 + (hd - 8) * 128 + (sub >> 3) * 64 + (sub & 1) * 32 + ((sub >> 1) & 3) * 8) = wv; }
    }
}
__device__ __forceinline__ void v8t_phase(const bf16* V, unsigned char* V8T, unsigned* vflag, int gw, int NGW, int lane) {
    const int qd = lane & 15, grp = lane >> 4;
    const int bytepos = (qd & 1) * 32 + (qd >> 3) * 16 + 4 * ((qd & 7) >> 1);
    float mx = 0.f;
    for (int i = gw; i < (TOK / 64) * 2 * 16 / 4; i += NGW) {
        const int it = i * 4 + grp, dblk = it & 15, kvh = (it >> 4) & 1, tg = it >> 5;
        const bf16* src = V + ((size_t)tg * 64 + qd * 4) * 256 + kvh * 128 + dblk * 8;
        const v4u r0 = *(const v4u*)src, r1 = *(const v4u*)(src + 256), r2 = *(const v4u*)(src + 512), r3 = *(const v4u*)(src + 768);
        unsigned char* dst = V8T + ((size_t)tg * 2 + kvh) * 8192 + (size_t)(dblk * 8) * 64 + bytepos;
#define V8_ONE(dd, F, C) do { const float a = F(r0.C), b = F(r1.C), c = F(r2.C), d = F(r3.C); mx = fmaxf(mx, fmaxf(fmaxf(fabsf(a), fabsf(b)), fmaxf(fabsf(c), fabsf(d)))); \
            int w = __builtin_amdgcn_cvt_pk_fp8_f32(a, b, 0, false); w = __builtin_amdgcn_cvt_pk_fp8_f32(c, d, w, true); *(unsigned*)(dst + (dd) * 64) = (unsigned)w; } while (0)
        V8_ONE(0, bflo, x); V8_ONE(1, bfhi, x); V8_ONE(2, bflo, y); V8_ONE(3, bfhi, y); V8_ONE(4, bflo, z); V8_ONE(5, bfhi, z); V8_ONE(6, bflo, w); V8_ONE(7, bfhi, w);
#undef V8_ONE
    }
    const unsigned fl = (__any(mx > 440.f) ? 1u : 0u) | (__any(mx >= 0.25f) ? 2u : 0u);
    if (lane == 0 && fl) atomicOr(vflag, fl);
}
__device__ __forceinline__ void poolwin_phase(const bf16* UP, bf16* Mo, int gt, int NGT) {
    for (int i = gt; i < (TOK / 8) * 64; i += NGT) {
        const int tg = i >> 6, ch = i & 63, g = ch >> 4, half = 1 << g, ta = tg * 8, tla = ta & (SEQ - 1);
        const bf16* base = UP + (size_t)(ta - tla) * 512 + ch * 8;
        v4u cen[8], ent[7], lev[7];
#pragma unroll
        for (int k = 0; k < 8; ++k) cen[k] = *(const v4u*)(base + (size_t)(tla + k) * 512);
#pragma unroll
        for (int k = 0; k < 7; ++k) { const int re = tla + k + half, rl = tla + k - half;
            ent[k] = *(const v4u*)(base + (size_t)(re < SEQ ? re : SEQ - 1) * 512); lev[k] = *(const v4u*)(base + (size_t)(rl >= 0 ? rl : 0) * 512); }
        float s[8] = {0.f, 0.f, 0.f, 0.f, 0.f, 0.f, 0.f, 0.f};
#define PW_ACC(v, sg) do { s[0] += (sg) * bflo((v).x); s[1] += (sg) * bfhi((v).x); s[2] += (sg) * bflo((v).y); s[3] += (sg) * bfhi((v).y); \
            s[4] += (sg) * bflo((v).z); s[5] += (sg) * bfhi((v).z); s[6] += (sg) * bflo((v).w); s[7] += (sg) * bfhi((v).w); } while (0)
        {
#pragma unroll
          for (int k = 0; k < 7; ++k) if (k < half) { PW_ACC(cen[k], 1.f); if (tla > 0) PW_ACC(lev[k], 1.f); }
          if (half == 8) { PW_ACC(cen[7], 1.f); if (tla > 0) { const v4u lev7 = *(const v4u*)(base + (size_t)(tla - 1) * 512); PW_ACC(lev7, 1.f); } } }
#pragma unroll
        for (int k = 0; k < 8; ++k) {
            const int tl = tla + k, lo = (tl - half > 0) ? tl - half : 0, hi = (tl + half < SEQ) ? tl + half : SEQ;
            const v4u c = cen[k];
            const float ic = 1.f / (float)(hi - lo);
            v4u o; o.x = pkbf(s[0] * ic - bflo(c.x), s[1] * ic - bfhi(c.x)); o.y = pkbf(s[2] * ic - bflo(c.y), s[3] * ic - bfhi(c.y));
            o.z = pkbf(s[4] * ic - bflo(c.z), s[5] * ic - bfhi(c.z)); o.w = pkbf(s[6] * ic - bflo(c.w), s[7] * ic - bfhi(c.w));
            *(v4u*)(Mo + (size_t)(ta + k) * 512 + ch * 8) = o;
            if (k < 7) { const float fe = (tl + half < SEQ) ? 1.f : 0.f, fl = (tl - half >= 0) ? -1.f : 0.f; PW_ACC(ent[k < 7 ? k : 0], fe); PW_ACC(lev[k < 7 ? k : 0], fl); }
        }
#undef PW_ACC
    }
}

__device__ __forceinline__ unsigned f2ord(float f) { const unsigned u = __builtin_bit_cast(unsigned, f); return (u & 0x80000000u) ? ~u : (u | 0x80000000u); }
__device__ __forceinline__ float ord2f(unsigned o) { const unsigned u = (o & 0x80000000u) ? (o & 0x7fffffffu) : ~o; return __builtin_bit_cast(float, u); }
#define TK_INSERT(L, xin) do { unsigned _x = (xin); _Pragma("unroll") for (int _i = 0; _i < 16; ++_i) { const unsigned _t = L[_i] > _x ? L[_i] : _x; _x = L[_i] > _x ? _x : L[_i]; L[_i] = _t; } } while (0)
#define TK_MERGE32(L) do { unsigned _P[16]; _Pragma("unroll") for (int _i = 0; _i < 16; ++_i) _P[_i] = (unsigned)shx_i<32>((int)L[_i], hi != 0); \
    _Pragma("unroll") for (int _i = 0; _i < 16; ++_i) L[_i] = L[_i] > _P[15 - _i] ? L[_i] : _P[15 - _i]; tk_bitonic_merge16(L); } while (0)

#define TK_CE(S, a, b) do { const unsigned _h = S[a] > S[b] ? S[a] : S[b], _l = S[a] > S[b] ? S[b] : S[a]; S[a] = _h; S[b] = _l; } while (0)
__device__ __forceinline__ void tk_sort16(unsigned (&S)[16]) {
    TK_CE(S, 0, 13); TK_CE(S, 1, 12); TK_CE(S, 2, 15); TK_CE(S, 3, 14); TK_CE(S, 4, 8); TK_CE(S, 5, 6); TK_CE(S, 7, 11); TK_CE(S, 9, 10);
    TK_CE(S, 0, 5); TK_CE(S, 1, 7); TK_CE(S, 2, 9); TK_CE(S, 3, 4); TK_CE(S, 6, 13); TK_CE(S, 8, 14); TK_CE(S, 10, 15); TK_CE(S, 11, 12);
    TK_CE(S, 0, 1); TK_CE(S, 2, 3); TK_CE(S, 4, 5); TK_CE(S, 6, 8); TK_CE(S, 7, 9); TK_CE(S, 10, 11); TK_CE(S, 12, 13); TK_CE(S, 14, 15);
    TK_CE(S, 0, 2); TK_CE(S, 1, 3); TK_CE(S, 4, 10); TK_CE(S, 5, 11); TK_CE(S, 6, 7); TK_CE(S, 8, 9); TK_CE(S, 12, 14); TK_CE(S, 13, 15);
    TK_CE(S, 1, 2); TK_CE(S, 3, 12); TK_CE(S, 4, 6); TK_CE(S, 5, 7); TK_CE(S, 8, 10); TK_CE(S, 9, 11); TK_CE(S, 13, 14);
    TK_CE(S, 1, 4); TK_CE(S, 2, 6); TK_CE(S, 5, 8); TK_CE(S, 7, 10); TK_CE(S, 9, 13); TK_CE(S, 11, 14);
    TK_CE(S, 2, 4); TK_CE(S, 3, 6); TK_CE(S, 9, 12); TK_CE(S, 11, 13);
    TK_CE(S, 3, 5); TK_CE(S, 6, 8); TK_CE(S, 7, 9); TK_CE(S, 10, 12);
    TK_CE(S, 3, 4); TK_CE(S, 5, 6); TK_CE(S, 7, 8); TK_CE(S, 9, 10); TK_CE(S, 11, 12);
    TK_CE(S, 6, 7); TK_CE(S, 8, 9);
}
__device__ __forceinline__ void tk_bitonic_merge16(unsigned (&S)[16]) {
    TK_CE(S, 0, 8); TK_CE(S, 1, 9); TK_CE(S, 2, 10); TK_CE(S, 3, 11); TK_CE(S, 4, 12); TK_CE(S, 5, 13); TK_CE(S, 6, 14); TK_CE(S, 7, 15);
    TK_CE(S, 0, 4); TK_CE(S, 1, 5); TK_CE(S, 2, 6); TK_CE(S, 3, 7); TK_CE(S, 8, 12); TK_CE(S, 9, 13); TK_CE(S, 10, 14); TK_CE(S, 11, 15);
    TK_CE(S, 0, 2); TK_CE(S, 1, 3); TK_CE(S, 4, 6); TK_CE(S, 5, 7); TK_CE(S, 8, 10); TK_CE(S, 9, 11); TK_CE(S, 12, 14); TK_CE(S, 13, 15);
    TK_CE(S, 0, 1); TK_CE(S, 2, 3); TK_CE(S, 4, 5); TK_CE(S, 6, 7); TK_CE(S, 8, 9); TK_CE(S, 10, 11); TK_CE(S, 12, 13); TK_CE(S, 14, 15);
}

__device__ __forceinline__ void wc8_phase(const bf16* WC, unsigned char* WC8, float* SWC, int gw, int NGW, int lane) {
    for (int row = gw; row < 2 * 2048; row += NGW) {
        const v4u r0 = *(const v4u*)(WC + (size_t)row * 1024 + lane * 16), r1 = *(const v4u*)(WC + (size_t)row * 1024 + lane * 16 + 8);
        float v[16] = {bflo(r0.x), bfhi(r0.x), bflo(r0.y), bfhi(r0.y), bflo(r0.z), bfhi(r0.z), bflo(r0.w), bfhi(r0.w), bflo(r1.x), bfhi(r1.x), bflo(r1.y), bfhi(r1.y), bflo(r1.z), bfhi(r1.z), bflo(r1.w), bfhi(r1.w)};
        float am = 0.f;
#pragma unroll
        for (int j = 0; j < 16; ++j) am = fmaxf(am, fabsf(v[j]));
        am = wave_max(am); const float sw = (am > 0.f) ? am * (1.f / 127.f) : 1.f, inv = 1.f / sw;
        v4u o; o.x = q8x4(v[0], v[1], v[2], v[3], inv); o.y = q8x4(v[4], v[5], v[6], v[7], inv); o.z = q8x4(v[8], v[9], v[10], v[11], inv); o.w = q8x4(v[12], v[13], v[14], v[15], inv);
        *(v4u*)(WC8 + (size_t)row * 1024 + lane * 16) = o; if (lane == 0) SWC[row] = sw;
    }
}
template <class Sched> __device__ __forceinline__ void topk_phase(const bf16* SP  , int* EIDX, float* GS, const Sched& S, int lane, int wave) {
    const int r32 = lane & 31, hi = lane >> 5;
#define TK_LOADQ(sq, tl, hh, p) do { const bf16* _s = SP + ((((((size_t)(tl) * 8 + (hh)) * 2 + (p)) * 4) * 2 + hi) * 32 + r32) * 16; _Pragma("unroll") for (int _kt = 0; _kt < 4; ++_kt) { sq[2 * _kt] = *(const v4u*)(_s + _kt * 1024); sq[2 * _kt + 1] = *(const v4u*)(_s + _kt * 1024 + 8); } } while (0)
#define TK_SELECT(sq, p, LOUT) do { unsigned L[16]; \
        _Pragma("unroll") for (int kt = 0; kt < 4; ++kt) { const v4u _a = sq[2 * kt], _b = sq[2 * kt + 1]; \
            const float sc[16] = {bflo(_a.x), bfhi(_a.x), bflo(_a.y), bfhi(_a.y), bflo(_a.z), bfhi(_a.z), bflo(_a.w), bfhi(_a.w), bflo(_b.x), bfhi(_b.x), bflo(_b.y), bfhi(_b.y), bflo(_b.z), bfhi(_b.z), bflo(_b.w), bfhi(_b.w)}; \
            unsigned S_[16]; _Pragma("unroll") for (int r = 0; r < 16; ++r) { const int n = kt * 32 + (r & 3) + 8 * (r >> 2) + 4 * hi; S_[r] = (f2ord(sc[r]) & 0xFFFFFF80u) | (unsigned)(127 - n); } \
            tk_sort16(S_); \
            if (kt == 0) { _Pragma("unroll") for (int i = 0; i < 16; ++i) L[i] = S_[i]; } \
            else { _Pragma("unroll") for (int i = 0; i < 16; ++i) L[i] = L[i] > S_[15 - i] ? L[i] : S_[15 - i]; tk_bitonic_merge16(L); } } \
        TK_MERGE32(L); _Pragma("unroll") for (int i = 0; i < 16; ++i) LOUT[i] = L[i]; } while (0)
    v4u bqA[8], bqB[8];
    pg8::Unit u, un;
    if (S.next(0, u)) TK_LOADQ(bqA, u.pm * 8 + wave, u.pn, 0);
    for (int ui = 0; S.next(ui, u); ++ui) {
        const int h = u.pn, tile = u.pm * 8 + wave, tok = tile * 32 + r32;
        unsigned LA[16], LB[16];
        TK_LOADQ(bqB, tile, h, 1);
        TK_SELECT(bqA, 0, LA);
        TK_SELECT(bqB, 1, LB);
        { const bool hn = S.next(ui + 1, un); TK_LOADQ(bqA, hn ? un.pm * 8 + wave : tile, hn ? un.pn : h, 0); }
        float va[16], vb[16];
#pragma unroll
        for (int i = 0; i < 16; ++i) { va[i] = ord2f(LA[i] & 0xFFFFFF80u); vb[i] = ord2f(LB[i] & 0xFFFFFF80u); }
        unsigned ta[4] = {0u, 0u, 0u, 0u}, tb[4] = {0u, 0u, 0u, 0u};
#pragma unroll
        for (int i = 0; i < 16; ++i) { ta[i >> 2] |= (127u - (LA[i] & 127u)) << ((i & 3) * 8); tb[i >> 2] |= (127u - (LB[i] & 127u)) << ((i & 3) * 8); }
        unsigned C[16];
#pragma unroll
        for (int j = 0; j < 16; ++j) { const unsigned key = (f2ord(va[0] + vb[j]) & 0xFFFFFF00u) | (unsigned)(255 - j); C[j] = hi ? 0u : key; }
        { const float _s = hi ? (va[1] + vb[1]) : (va[1] + vb[0]); const unsigned _id = hi ? 238u : 239u; const unsigned key = (f2ord(_s) & 0xFFFFFF00u) | _id; TK_INSERT(C, key); }
        { const float _s = hi ? (va[1] + vb[3]) : (va[1] + vb[2]); const unsigned _id = hi ? 236u : 237u; const unsigned key = (f2ord(_s) & 0xFFFFFF00u) | _id; TK_INSERT(C, key); }
        { const float _s = hi ? (va[1] + vb[5]) : (va[1] + vb[4]); const unsigned _id = hi ? 234u : 235u; const unsigned key = (f2ord(_s) & 0xFFFFFF00u) | _id; TK_INSERT(C, key); }
        { const float _s = hi ? (va[1] + vb[7]) : (va[1] + vb[6]); const unsigned _id = hi ? 232u : 233u; const unsigned key = (f2ord(_s) & 0xFFFFFF00u) | _id; TK_INSERT(C, key); }
        { const float _s = hi ? (va[2] + vb[1]) : (va[2] + vb[0]); const unsigned _id = hi ? 222u : 223u; const unsigned key = (f2ord(_s) & 0xFFFFFF00u) | _id; TK_INSERT(C, key); }
        { const float _s = hi ? (va[2] + vb[3]) : (va[2] + vb[2]); const unsigned _id = hi ? 220u : 221u; const unsigned key = (f2ord(_s) & 0xFFFFFF00u) | _id; TK_INSERT(C, key); }
        { const float _s = hi ? (va[3] + vb[0]) : (va[2] + vb[4]); const unsigned _id = hi ? 207u : 219u; const unsigned key = (f2ord(_s) & 0xFFFFFF00u) | _id; TK_INSERT(C, key); }
        { const float _s = hi ? (va[3] + vb[2]) : (va[3] + vb[1]); const unsigned _id = hi ? 205u : 206u; const unsigned key = (f2ord(_s) & 0xFFFFFF00u) | _id; TK_INSERT(C, key); }
        { const float _s = hi ? (va[4] + vb[0]) : (va[3] + vb[3]); const unsigned _id = hi ? 191u : 204u; const unsigned key = (f2ord(_s) & 0xFFFFFF00u) | _id; TK_INSERT(C, key); }
        { const float _s = hi ? (va[4] + vb[2]) : (va[4] + vb[1]); const unsigned _id = hi ? 189u : 190u; const unsigned key = (f2ord(_s) & 0xFFFFFF00u) | _id; TK_INSERT(C, key); }
        { const float _s = hi ? (va[5] + vb[1]) : (va[5] + vb[0]); const unsigned _id = hi ? 174u : 175u; const unsigned key = (f2ord(_s) & 0xFFFFFF00u) | _id; TK_INSERT(C, key); }
        { const float _s = hi ? (va[6] + vb[1]) : (va[6] + vb[0]); const unsigned _id = hi ? 158u : 159u; const unsigned key = (f2ord(_s) & 0xFFFFFF00u) | _id; TK_INSERT(C, key); }
        { const float _s = hi ? (va[7] + vb[1]) : (va[7] + vb[0]); const unsigned _id = hi ? 142u : 143u; const unsigned key = (f2ord(_s) & 0xFFFFFF00u) | _id; TK_INSERT(C, key); }
        { const float _s = hi ? (va[9] + vb[0]) : (va[8] + vb[0]); const unsigned _id = hi ? 111u : 127u; const unsigned key = (f2ord(_s) & 0xFFFFFF00u) | _id; TK_INSERT(C, key); }
        { const float _s = hi ? (va[11] + vb[0]) : (va[10] + vb[0]); const unsigned _id = hi ? 79u : 95u; const unsigned key = (f2ord(_s) & 0xFFFFFF00u) | _id; TK_INSERT(C, key); }
        { const float _s = hi ? (va[13] + vb[0]) : (va[12] + vb[0]); const unsigned _id = hi ? 47u : 63u; const unsigned key = (f2ord(_s) & 0xFFFFFF00u) | _id; TK_INSERT(C, key); }
        { const float _s = hi ? (va[15] + vb[0]) : (va[14] + vb[0]); const unsigned _id = hi ? 15u : 31u; const unsigned key = (f2ord(_s) & 0xFFFFFF00u) | _id; TK_INSERT(C, key); }
        TK_MERGE32(C);
        const float smax = ord2f(C[0] & 0xFFFFFF00u);
        float ev[16]; float esum = 0.f; int ei[16];
#pragma unroll
        for (int k = 0; k < 16; ++k) {
            const unsigned cid = 255u - (C[k] & 255u), ci = cid >> 4, cj = cid & 15u;
            const unsigned wa = (ci & 8u) ? ((ci & 4u) ? ta[3] : ta[2]) : ((ci & 4u) ? ta[1] : ta[0]);
            const unsigned wb = (cj & 8u) ? ((cj & 4u) ? tb[3] : tb[2]) : ((cj & 4u) ? tb[1] : tb[0]);
            const unsigned ia = (wa >> ((ci & 3u) * 8u)) & 255u, ib = (wb >> ((cj & 3u) * 8u)) & 255u;
            ei[k] = (int)(ia * 128u + ib);
            ev[k] = __expf(ord2f(C[k] & 0xFFFFFF00u) - smax); esum += ev[k];
        }
        const float inv = 1.f / esum;
        if (hi == 0) { int* ep = EIDX + (size_t)tok * 128 + h * 16;
#pragma unroll
            for (int q = 0; q < 4; ++q) { v4u o; o.x = (unsigned)ei[4 * q]; o.y = (unsigned)ei[4 * q + 1]; o.z = (unsigned)ei[4 * q + 2]; o.w = (unsigned)ei[4 * q + 3]; *(v4u*)(ep + 4 * q) = o; }
        } else { float* gp = GS + (size_t)tok * 128 + h * 16;
#pragma unroll
            for (int q = 0; q < 4; ++q) { f32x4 o; o[0] = ev[4 * q] * inv; o[1] = ev[4 * q + 1] * inv; o[2] = ev[4 * q + 2] * inv; o[3] = ev[4 * q + 3] * inv; *(f32x4*)(gp + 4 * q) = o; }
        }
    }
}

#undef TK_LOADQ
#undef TK_SELECT
constexpr float V_SCALE = 16.f;
__device__ __forceinline__ f32x2 fp8lo(unsigned w) { return __builtin_amdgcn_cvt_pk_f32_fp8((int)w, false); }
__device__ __forceinline__ f32x2 fp8hi(unsigned w) { return __builtin_amdgcn_cvt_pk_f32_fp8((int)w, true); }
__device__ __forceinline__ void cvt16_fp8_range(const float* src, unsigned char* dst, size_t n16, float scale, int gt, int NGT) {
    for (size_t i = gt; i < n16; i += NGT) {
        const f32x4 a = *(const f32x4*)(src + i * 16) * scale, b = *(const f32x4*)(src + i * 16 + 4) * scale, c = *(const f32x4*)(src + i * 16 + 8) * scale, d = *(const f32x4*)(src + i * 16 + 12) * scale;
        v4u o; int w;
        w = __builtin_amdgcn_cvt_pk_fp8_f32(a[0], a[1], 0, false); w = __builtin_amdgcn_cvt_pk_fp8_f32(a[2], a[3], w, true); o.x = (unsigned)w;
        w = __builtin_amdgcn_cvt_pk_fp8_f32(b[0], b[1], 0, false); w = __builtin_amdgcn_cvt_pk_fp8_f32(b[2], b[3], w, true); o.y = (unsigned)w;
        w = __builtin_amdgcn_cvt_pk_fp8_f32(c[0], c[1], 0, false); w = __builtin_amdgcn_cvt_pk_fp8_f32(c[2], c[3], w, true); o.z = (unsigned)w;
        w = __builtin_amdgcn_cvt_pk_fp8_f32(d[0], d[1], 0, false); w = __builtin_amdgcn_cvt_pk_fp8_f32(d[2], d[3], w, true); o.w = (unsigned)w;
        *(v4u*)(dst + i * 16) = o;
    }
}
__device__ __forceinline__ void cvt16_fp8_chunked(const float* src, unsigned char* dst, float scale, int gt, int NGT) {
    constexpr size_t NI = (size_t)DEPTH * NEXP * 64;
    for (size_t i0 = gt; i0 < NI; i0 += (size_t)NGT * 4) {
        f32x4 va[4], vb[4], vc[4], vd[4];
#pragma unroll
        for (int u = 0; u < 4; ++u) { const size_t i = i0 + (size_t)u * NGT; const float* sp = src + (i < NI ? i : i0) * 16;
            va[u] = *(const f32x4*)(sp) * scale; vb[u] = *(const f32x4*)(sp + 4) * scale; vc[u] = *(const f32x4*)(sp + 8) * scale; vd[u] = *(const f32x4*)(sp + 12) * scale; }
#pragma unroll
        for (int u = 0; u < 4; ++u) { const size_t i = i0 + (size_t)u * NGT; if (i >= NI) break;
            const size_t l = i >> 20, rem = i & ((1u << 20) - 1u), e = rem >> 6, r = rem & 63, c = r >> 3, j = (r & 7) * 16;
            const f32x4 a = va[u], b = vb[u], cc = vc[u], d = vd[u];
            v4u o; int w;
            w = __builtin_amdgcn_cvt_pk_fp8_f32(a[0], a[1], 0, false); w = __builtin_amdgcn_cvt_pk_fp8_f32(a[2], a[3], w, true); o.x = (unsigned)w;
            w = __builtin_amdgcn_cvt_pk_fp8_f32(b[0], b[1], 0, false); w = __builtin_amdgcn_cvt_pk_fp8_f32(b[2], b[3], w, true); o.y = (unsigned)w;
            w = __builtin_amdgcn_cvt_pk_fp8_f32(cc[0], cc[1], 0, false); w = __builtin_amdgcn_cvt_pk_fp8_f32(cc[2], cc[3], w, true); o.z = (unsigned)w;
            w = __builtin_amdgcn_cvt_pk_fp8_f32(d[0], d[1], 0, false); w = __builtin_amdgcn_cvt_pk_fp8_f32(d[2], d[3], w, true); o.w = (unsigned)w;
            *(v4u*)(dst + (l << 24) + ((c * NEXP + e) * 128 + j)) = o; }
    }
}
__device__ __forceinline__ void cvt_u_int8_chunked(const float* src, unsigned char* dst, float* SU, int gw, int NGW, int lane) {
    for (int rb = gw * 4; rb < DEPTH * NEXP; rb += NGW * 4) {
        f32x4 va[4], vb[4], vc[4], vd[4];
#pragma unroll
        for (int u = 0; u < 4; ++u) { const float* sp = src + (size_t)(rb + u) * 1024 + lane * 16; va[u] = *(const f32x4*)(sp); vb[u] = *(const f32x4*)(sp + 4); vc[u] = *(const f32x4*)(sp + 8); vd[u] = *(const f32x4*)(sp + 12); }
#pragma unroll
        for (int u = 0; u < 4; ++u) { const int row = rb + u, l = row >> 14, e = row & (NEXP - 1);
            const f32x4 a = va[u], b = vb[u], c = vc[u], d = vd[u];
            float am = fmaxf(fmaxf(fmaxf(fabsf(a[0]), fabsf(a[1])), fmaxf(fabsf(a[2]), fabsf(a[3]))), fmaxf(fmaxf(fabsf(b[0]), fabsf(b[1])), fmaxf(fabsf(b[2]), fabsf(b[3]))));
            am = fmaxf(am, fmaxf(fmaxf(fmaxf(fabsf(c[0]), fabsf(c[1])), fmaxf(fabsf(c[2]), fabsf(c[3]))), fmaxf(fmaxf(fabsf(d[0]), fabsf(d[1])), fmaxf(fabsf(d[2]), fabsf(d[3])))));
            am = wave_max(am); const float su = (am > 0.f) ? am * (1.f / 127.f) : 1.f, inv = 1.f / su;
            v4u o; o.x = q8x4(a[0], a[1], a[2], a[3], inv); o.y = q8x4(b[0], b[1], b[2], b[3], inv); o.z = q8x4(c[0], c[1], c[2], c[3], inv); o.w = q8x4(d[0], d[1], d[2], d[3], inv);
            *(v4u*)(dst + ((size_t)l << 24) + (((size_t)(lane >> 3) * NEXP + e) * 128 + (lane & 7) * 16)) = o;
            if (lane == 0) SU[row] = su; }
    }
}
template <bool LAST, int GABL = 0, bool DRY = false>
__device__ __forceinline__ void gather_phase(const bf16* XF, const int* EIDX, const float* GS, const unsigned char* EU, const unsigned char* EV, bf16* XS  , float* XOUT  , const float* g2p  ,
                                             const float* wnext, const float* modn  , unsigned char* XQN  , float* SXN  , LAS unsigned char* lds, int gw, int NGW, int wave, int lane, int nrep  ,
                                             const unsigned char* XQ  , const float* SX  , const float* SU  ) {
    const int g = lane >> 3, s = lane & 7, b5 = lane & 32, b4 = lane & 16, b3 = lane & 8, s4 = lane & 4, s2 = lane & 2, s1 = lane & 1;
    LAS float* H = (LAS float*)(lds + wave * 8192);
    LAS float* SSL = (LAS float*)(lds + 65536 + wave * 4096);
#define LOAD_EV(dst, t) do { const v4u* _p = (const v4u*)(EIDX + (size_t)(t) * 128 + g * 16); dst[0] = _p[0]; dst[1] = _p[1]; dst[2] = _p[2]; dst[3] = _p[3]; } while (0)
#define EVI(ev, i) ((ev)[(i) >> 2][(i) & 3])
#define ROW(T, c, e) (*(const v4u*)(((T) + (size_t)(c) * NEXP * 128) + (((unsigned)(e) << 7) + (unsigned)(s * 16))))
    for (int grp = gw; grp < TOK / 16; grp += NGW) {
        const int t0 = grp * 16, b = t0 >> 13;
        for (int rep = 0; rep < nrep; ++rep) {
        constexpr bool ab1 = (GABL & 1) != 0, ab2 = (GABL & 2) != 0;
        {
            v4u ev0[4], ev1[4], ev2[4], r[16], xr;
            LOAD_EV(ev0, t0); LOAD_EV(ev1, t0 + 1);
            xr = *(const v4u*)(XQ + (size_t)t0 * 1024 + s * 16);
#pragma unroll
            for (int i = 0; i < 16; ++i) r[i] = ROW(EU, 0, EVI(ev0, i));
#pragma unroll 1
            for (int it = 0; it < 128; ++it) {
                const int c = it >> 4, tt = it & 15, itn = (it < 127) ? it + 1 : 127, cn = itn >> 4, ttn = itn & 15;
                const v4u xq = xr;
                xr = *(const v4u*)(XQ + (size_t)(t0 + ttn) * 1024 + cn * 128 + s * 16);
                LOAD_EV(ev2, t0 + ((it + 2) & 15));
                int pp[16];
#pragma unroll
                for (int i = 0; i < 16; ++i) {
                    if (ab1) { asm volatile("" :: "v"(r[i])); pp[i] = 0; } else {
                    int sm = __builtin_amdgcn_sdot4((int)r[i].x, (int)xq.x, 0, false); sm = __builtin_amdgcn_sdot4((int)r[i].y, (int)xq.y, sm, false);
                    sm = __builtin_amdgcn_sdot4((int)r[i].z, (int)xq.z, sm, false); pp[i] = __builtin_amdgcn_sdot4((int)r[i].w, (int)xq.w, sm, false); }
                    if (!ab2) r[i] = ROW(EU, cn, EVI(ev1, i));
                    if ((i & 3) == 3) __builtin_amdgcn_sched_barrier(0);
                }
                int q8[8], q4[4], q2[2];
#pragma unroll
                for (int j = 0; j < 8; ++j) { const int keep = s4 ? pp[j + 8] : pp[j], send = s4 ? pp[j] : pp[j + 8]; q8[j] = keep + __builtin_amdgcn_update_dpp(0, send, 0x141, 0xF, 0xF, false); }
#pragma unroll
                for (int j = 0; j < 4; ++j) { const int keep = s2 ? q8[j + 4] : q8[j], send = s2 ? q8[j] : q8[j + 4]; q4[j] = keep + shx_i<2>(send, false); }
#pragma unroll
                for (int j = 0; j < 2; ++j) { const int keep = s1 ? q4[j + 2] : q4[j], send = s1 ? q4[j] : q4[j + 2]; q2[j] = keep + shx_i<1>(send, false); }
                typedef int i32x2 __attribute__((ext_vector_type(2)));
                LAS i32x2* hp = (LAS i32x2*)(H + tt * 128 + 2 * lane);
                i32x2 hv = i32x2{q2[0], q2[1]};
                if (c != 0) hv += *hp;
                *hp = hv;
#pragma unroll
                for (int q = 0; q < 4; ++q) { ev0[q] = ev1[q]; ev1[q] = ev2[q]; }
            }
        }
        {   typedef int i32x2 __attribute__((ext_vector_type(2)));
#pragma unroll 1
            for (int tb = 0; tb < 16; tb += 4) {
                i32x2 hi2[4], e2[4]; f32x2 g2[4]; float sx[4], su0[4], su1[4];
#pragma unroll
                for (int u = 0; u < 4; ++u) { const int tt = tb + u; hi2[u] = *(const LAS i32x2*)(H + tt * 128 + 2 * lane); e2[u] = *(const i32x2*)(EIDX + (size_t)(t0 + tt) * 128 + 2 * lane);
                    sx[u] = SX[t0 + tt]; g2[u] = *(const f32x2*)(GS + (size_t)(t0 + tt) * 128 + 2 * lane); }
#pragma unroll
                for (int u = 0; u < 4; ++u) { su0[u] = SU[e2[u].x]; su1[u] = SU[e2[u].y]; }
#pragma unroll
                for (int u = 0; u < 4; ++u) { const int tt = tb + u;
                    f32x2 h2; h2.x = (float)hi2[u].x * (sx[u] * su0[u]); h2.y = (float)hi2[u].y * (sx[u] * su1[u]);
                    f32x2 a2; a2.x = 0.5f * h2.x * (1.f + erff(h2.x * 0.70710678118654752f)) * g2[u].x; a2.y = 0.5f * h2.y * (1.f + erff(h2.y * 0.70710678118654752f)) * g2[u].y;
                    *(LAS f32x2*)(H + tt * 128 + 2 * lane) = a2; }
            }
        }
        {
            v4u ev0[4], ev1[4], ev2[4], r[16];
            LOAD_EV(ev0, t0); LOAD_EV(ev1, t0 + 1);
#pragma unroll
            for (int i = 0; i < 16; ++i) r[i] = ROW(EV, 0, EVI(ev0, i));
#pragma unroll 1
            for (int it = 0; it < 128; ++it) {
                const int c = it >> 4, tt = it & 15, itn = (it < 127) ? it + 1 : 127, cn = itn >> 4;
                const int colp = c * 128 + s * 16 + 2 * g; const unsigned xraw = *(const unsigned*)(XS + (size_t)(t0 + tt) * 2048 + 1024 + colp); const f32x2 xi = f32x2{bflo(xraw), bfhi(xraw)}, gg = *(const f32x2*)(g2p + (size_t)b * 6144 + colp);
                f32x4 av[4];
#pragma unroll
                for (int q = 0; q < 4; ++q) av[q] = *(const LAS f32x4*)(H + tt * 128 + g * 16 + 4 * q);
                LOAD_EV(ev2, t0 + ((it + 2) & 15));
                f32x2 o[8];
#pragma unroll
                for (int i = 0; i < 8; ++i) o[i] = f32x2{0.f, 0.f};
#pragma unroll
                for (int i = 0; i < 16; ++i) {
                    const float a = av[i >> 2][i & 3]; const f32x2 a2 = f32x2{a, a};
                    if (ab1) { asm volatile("" :: "v"(r[i]), "v"(a2)); } else {
                    o[0] += a2 * fp8lo(r[i].x); o[1] += a2 * fp8hi(r[i].x); o[2] += a2 * fp8lo(r[i].y); o[3] += a2 * fp8hi(r[i].y);
                    o[4] += a2 * fp8lo(r[i].z); o[5] += a2 * fp8hi(r[i].z); o[6] += a2 * fp8lo(r[i].w); o[7] += a2 * fp8hi(r[i].w); }
                    if (!ab2) r[i] = ROW(EV, cn, EVI(ev1, i));
                    if ((i & 3) == 3) __builtin_amdgcn_sched_barrier(0);
                }
                float q8[8], q4[4], q2[2];
#pragma unroll
                for (int j = 0; j < 8; ++j) { const float lo = (j & 1) ? o[j >> 1].y : o[j >> 1].x, hi_ = (j & 1) ? o[(j + 8) >> 1].y : o[(j + 8) >> 1].x;
                    const float keep = b5 ? hi_ : lo, send = b5 ? lo : hi_; q8[j] = keep + shx<32>(send, b5 != 0); }
#pragma unroll
                for (int j = 0; j < 4; ++j) { const float keep = b4 ? q8[j + 4] : q8[j], send = b4 ? q8[j] : q8[j + 4]; q4[j] = keep + shx16p(send, b4 != 0); }
#pragma unroll
                for (int j = 0; j < 2; ++j) { const float keep = b3 ? q4[j + 2] : q4[j], send = b3 ? q4[j] : q4[j + 2]; q2[j] = keep + shx<8>(send); }
                const int col = c * 128 + s * 16 + 2 * g, t = t0 + tt;
                bf16* xp = XS + (size_t)t * 2048 + 1024 + col;
                f32x2 x2; x2.x = xi.x + gg.x * (q2[0] * (1.f / V_SCALE)); x2.y = xi.y + gg.y * (q2[1] * (1.f / V_SCALE));
                if (!DRY && rep + 1 == nrep) *(unsigned*)xp = pkbf(x2.x, x2.y);
                float sq = x2.x * x2.x + x2.y * x2.y;
                if (c != 0) sq += SSL[tt * 64 + lane];
                SSL[tt * 64 + lane] = sq;
#pragma unroll
                for (int q = 0; q < 4; ++q) { ev0[q] = ev1[q]; ev1[q] = ev2[q]; }
            }
        }
        }
        if (DRY) continue;
        asm volatile("s_waitcnt vmcnt(0)" ::: "memory");
        {
            f32x4 PA[4], PB[4];
#pragma unroll
            for (int q = 0; q < 4; ++q) { const f32x4 wv = *(const f32x4*)(wnext + lane * 16 + 4 * q);
                if (LAST) { PA[q] = wv; PB[q] = f32x4{0.f, 0.f, 0.f, 0.f}; }
                else { PA[q] = wv * (*(const f32x4*)(modn + (size_t)b * 6144 + 1024 + lane * 16 + 4 * q) + 1.f); PB[q] = *(const f32x4*)(modn + (size_t)b * 6144 + lane * 16 + 4 * q); } }
#pragma unroll 1
            for (int tb = 0; tb < 16; tb += 4) {
                f32x4 xv4[4][4]; float rs[4];
#pragma unroll
                for (int u = 0; u < 4; ++u) { const bf16* xr = XS + (size_t)(t0 + tb + u) * 2048 + 1024 + lane * 16; rs[u] = SSL[(tb + u) * 64 + lane];
                    const v4u r0 = __builtin_nontemporal_load((const v4u*)xr), r1 = __builtin_nontemporal_load((const v4u*)(xr + 8));
                    xv4[u][0] = f32x4{bflo(r0.x), bfhi(r0.x), bflo(r0.y), bfhi(r0.y)}; xv4[u][1] = f32x4{bflo(r0.z), bfhi(r0.z), bflo(r0.w), bfhi(r0.w)};
                    xv4[u][2] = f32x4{bflo(r1.x), bfhi(r1.x), bflo(r1.y), bfhi(r1.y)}; xv4[u][3] = f32x4{bflo(r1.z), bfhi(r1.z), bflo(r1.w), bfhi(r1.w)}; }
#pragma unroll
                for (int u = 0; u < 4; ++u) { const int t = t0 + tb + u; float* xr = XOUT + (size_t)t * 1024 + lane * 16;
                    const float rstd = rsqrtf(wave_sum(rs[u]) * (1.f / 1024.f) + EPS);
                    f32x4 yq[4]; float am = 0.f;
#pragma unroll
                    for (int q = 0; q < 4; ++q) { const f32x4 y = xv4[u][q] * rstd * PA[q] + PB[q]; yq[q] = y;
                        if (LAST) { *(f32x4*)(xr + 4 * q) = y; }
                        else am = fmaxf(fmaxf(am, fmaxf(fabsf(y[0]), fabsf(y[1]))), fmaxf(fabsf(y[2]), fabsf(y[3]))); }
                    if (!LAST) { am = wave_max(am); const float sx = (am > 0.f) ? am * (1.f / 127.f) : 1.f, inv = 1.f / sx;
                        v4u xo; xo.x = q8x4(yq[0][0], yq[0][1], yq[0][2], yq[0][3], inv); xo.y = q8x4(yq[1][0], yq[1][1], yq[1][2], yq[1][3], inv);
                        xo.z = q8x4(yq[2][0], yq[2][1], yq[2][2], yq[2][3], inv); xo.w = q8x4(yq[3][0], yq[3][1], yq[3][2], yq[3][3], inv);
                        *(v4u*)(XQN + (size_t)t * 1024 + lane * 16) = xo; if (lane == 0) SXN[t] = sx; } }
            }
        }
    }
#undef LOAD_EV
#undef EVI
#undef ROW
}


#ifndef ATTN_CHECK
#define ATTN_CHECK 0
#endif
#if ATTN_CHECK
constexpr int CW_FLAG = 64;
__device__ __forceinline__ void attn_check(const bf16* Q, const bf16* K, const bf16* V, const bf16* Ot, unsigned* flag, LAS unsigned char* lds, int tid, int bid, const float* qw, const f32x2* rt) {
    LAS float* sc = (LAS float*)lds;
    LAS float* red = (LAS float*)(lds + 32768);
    for (int j = 0; j < 4; ++j) {
        const int sid = bid * 4 + j, b = sid & 3, h = (sid >> 2) & 7, t = (int)(((unsigned)sid * 2654435761u) >> 7) & 8191, kvh = h >> 2;
        const bf16* q = Q + ((size_t)(b * SEQ + t)) * 1024 + h * 128;
        LAS float* qn = (LAS float*)(lds + 36864);
        { float v = (tid < 128) ? bflo((unsigned)q[tid]) : 0.f; red[tid] = v * v; __syncthreads();
          if (tid == 0) { float m = 0.f; for (int i2 = 0; i2 < 128; ++i2) m += red[i2]; red[0] = rsqrtf(m / 128.f + 1e-6f); } __syncthreads();
          const float rs = red[0]; __syncthreads();
          if (tid < 128) red[tid] = v * rs * qw[tid]; __syncthreads();
          if (tid < 128) { const int sec = tid >> 6, din = tid & 63, i2 = din & 31, pos = sec ? 128 + (t & 63) : (t >> 6); const f32x2 c2 = rt[pos * 32 + i2];
              const float me = red[tid], pr = red[tid ^ 32]; qn[tid] = ((din < 32) ? (me * c2.x - pr * c2.y) : (me * c2.x + pr * c2.y)) * (0.088388347648318440f * 1.4426950408889634f); }
          __syncthreads(); }
        float mx = -1e30f;
        for (int s = tid; s < SEQ; s += NTHR) { const bf16* kr = K + ((size_t)(b * SEQ + s)) * 256 + kvh * 128; float d = 0.f;
            for (int e = 0; e < 128; ++e) d += qn[e] * bflo((unsigned)kr[e]);
            d *= 0.6931471805599453f; sc[s] = d;     mx = fmaxf(mx, d); }
        red[tid] = mx; __syncthreads();
        if (tid == 0) { float m = red[0]; for (int i = 1; i < NTHR; ++i) m = fmaxf(m, red[i]); red[0] = m; } __syncthreads();
        mx = red[0]; __syncthreads();
        float sm = 0.f; for (int s = tid; s < SEQ; s += NTHR) { const float p = expf(sc[s] - mx); sc[s] = p; sm += p; }
        red[tid] = sm; __syncthreads();
        if (tid == 0) { float m = 0.f; for (int i = 0; i < NTHR; ++i) m += red[i]; red[0] = m; } __syncthreads();
        const float inv = 1.f / red[0]; __syncthreads();
        float o = 0.f, ot = 0.f;
        if (tid < 128) { for (int s = 0; s < SEQ; ++s) o += sc[s] * bflo((unsigned)V[((size_t)(b * SEQ + s)) * 256 + (ATTN_CHECK == 2 ? (kvh ^ 1) : kvh) * 128 + tid]); o *= inv;
            ot = bflo((unsigned)Ot[((size_t)(b * SEQ + t)) * 1024 + h * 128 + tid]); }
        red[tid] = (tid < 128) ? o * o : 0.f; red[tid] = red[tid]; __syncthreads();
        if (tid == 0) { float m = 0.f; for (int i = 0; i < 128; ++i) m += red[i]; red[0] = sqrtf(m / 128.f); } __syncthreads();
        const float rms = red[0]; __syncthreads();
        red[tid] = (tid < 128) ? (o - ot) * (o - ot) : 0.f; __syncthreads();
        if (tid == 0) { float m = 0.f; for (int i = 0; i < 128; ++i) m += red[i]; if (!(sqrtf(m / 128.f) <= 0.2f * rms + 1e-6f)) atomicOr(flag, 1u); } __syncthreads();
        if (tid < 128 && !(fabsf(o - ot) <= 0.6f * rms + 1e-6f)) atomicOr(flag, 1u);
        __syncthreads();
    }
}
#endif
constexpr int N_PHASES = 1 + 11 * DEPTH;
#ifndef PH_MASK
#define PH_MASK 0xFFFF
#endif
#define PHON(k) (((PH_MASK) >> (k)) & 1)
#ifndef REP_MASK
#define REP_MASK 0
#endif
#define REPK(k) (((REP_MASK) >> (k)) & 1)
__global__ void __launch_bounds__(NTHR, 2) mega(Args a) {
    extern __shared__ __attribute__((aligned(16))) unsigned char lds_raw[];
    LAS unsigned char* lds = (LAS unsigned char*)lds_raw;
    const int bid = blockIdx.x, G = gridDim.x;
#define tid0 ((int)threadIdx.x)
    const int NGW = G * NWAVES, NGT = G * NTHR;
    unsigned char* ws = a.ws;
    volatile LAS unsigned* MISC = (volatile LAS unsigned*)(lds + LDSCTL_OFF);
    for (int u = tid0; u < (LDS_BYTES - LDSCTL_OFF) / 4; u += NTHR) MISC[u] = 0u;
    __syncthreads();
    const int lo = a.ph_lo, hi = a.ph_hi;
    XcdBarrier bar; bar.bar = (unsigned*)(ws + WS_CTL) + CW_BAR; bar.x = 0; bar.st = nullptr;
    if (hi - lo > 1) bar = xcd_barrier_post((unsigned*)(ws + WS_CTL) + CW_BAR, MISC + 8);
#define IN(k) (lo <= (k) && (k) < hi)
#ifndef BAR_REP
#define BAR_REP 1
#endif
#define SEAM(k) do { if (IN(k) && IN((k) + 1)) for (int _b = 0; _b < BAR_REP; ++_b) xcd_barrier(bar); } while (0)

#define MOD ((float*)(ws + WS_MOD))
#define XN ((bf16*)(ws + WS_XN))
#define Qb ((bf16*)(ws + WS_Q))
#define Kb ((bf16*)(ws + WS_K))
#define Vb ((bf16*)(ws + WS_V))
#define UPb ((bf16*)(ws + WS_UP))
#define GAb ((bf16*)(ws + WS_GA))
#define GPb ((bf16*)(ws + WS_GP))
#define Mb ((bf16*)(ws + WS_XN))
#define QPb ((bf16*)(ws + WS_PROJ))
#define EIDX ((int*)(ws + WS_EIDX))
#define GSb ((float*)(ws + WS_GS))
#define EUb ((const unsigned char*)(ws + WS_EXPU))
#define EVb ((const unsigned char*)(ws + WS_EXPV))

    if (PHON(0) && IN(0)) for (int rep = 0; rep <= REPK(0); ++rep) { const int w0 = __builtin_amdgcn_readfirstlane(tid0 >> 6);
        p0_prologue(a, lds, tid0, tid0 & 63, w0, bid, G, 0);
        if (w0 & 1) { cvt_u_int8_chunked(a.expert_u, ws + WS_EXPU, (float*)(ws + WS_SU), bid * NWAVES + w0, NGW, tid0 & 63); cvt16_fp8_chunked(a.expert_v, ws + WS_EXPV, V_SCALE, bid * NTHR + tid0, NGT); p0_prologue(a, lds, tid0, tid0 & 63, w0, bid, G, 1); }
        else { p0_prologue(a, lds, tid0, tid0 & 63, w0, bid, G, 1); cvt_u_int8_chunked(a.expert_u, ws + WS_EXPU, (float*)(ws + WS_SU), bid * NWAVES + w0, NGW, tid0 & 63); cvt16_fp8_chunked(a.expert_v, ws + WS_EXPV, V_SCALE, bid * NTHR + tid0, NGT); }
        __syncthreads(); }
    SEAM(0);

    for (int l = 0; l < DEPTH; ++l) {
        const int pb = 1 + 11 * l;
        unsigned char* ws;
        { unsigned long long wsi = (unsigned long long)a.ws; asm volatile("" : "+s"(wsi)); ws = (unsigned char*)(GAS unsigned char*)wsi; }
        int tid = tid0; asm volatile("" : "+v"(tid));
        int lane = tid & 63, wave = __builtin_amdgcn_readfirstlane(tid >> 6), gw = bid * NWAVES + wave, gt = bid * NTHR + tid;
#define modl (MOD + (size_t)l * 4 * 6144)
        bool att_nomax = true;
        if (PHON(1) && IN(pb + 0) && l == 0) for (int rep = 0; rep <= REPK(1); ++rep) normmod_phase(a.x, a.norm_mix_w, modl, 0, 1024, nullptr  , gw, NGW, lane, (unsigned*)(ws + WS_XQ2), (float*)(ws + WS_SX2));
        if (PHON(1) && IN(pb + 0) && l == 0) { for (int it = gw; it < 2 * 1024; it += NGW) { const int ll = (it >> 10) & 1;
                win8_item(a.w_in + (size_t)ll * 1024 * 4096, (const unsigned*)(ws + WS_CTL) + CW_CMAX + ll * 4096, ws + WS_WIN + (size_t)ll * 4096 * 1024, (float*)(ws + WS_SWIN) + ll * 4096, it & 1023, lane); }
            __syncthreads();
            for (int ll = 0; ll < 2; ++ll) {
                pg8::Gemm g{(const bf16*)(ws + WS_ABD) + (size_t)ll * 2048 * 4096, (const bf16*)(ws + WS_WQB) + (size_t)ll * 1024 * 4096, 2048, 1024, 4096, 8, 512 * 2};     pg8::StaticOrder S; S.init(2048, 1024, G, (bid + ll * (G / 2)) % G);
                pg8::EpiB<0> E{(bf16*)(ws + WS_WC) + (size_t)ll * 2048 * 1024, 1024, nullptr, nullptr, nullptr, nullptr, nullptr, nullptr, nullptr, nullptr};
                pg8::gemm_phase<pg8::EpiB<0>, pg8::StaticOrder, true, true>(lds, g, S, E); __syncthreads(); } }
        SEAM(pb + 0);
        if (PHON(2) && IN(pb + 1)) {
            pg8::Gemm g{(const bf16*)(ws + WS_XQ2), (const bf16*)(ws + WS_WIN + (size_t)l * 4096 * 1024), TOK, INC, DM / 2}; pg8::StaticOrder S; S.init(TOK, INC, G, bid);
            pg8::EpiB<1> E{nullptr, 0, nullptr, nullptr, Qb, Kb, Vb, UPb, GAb, GPb, (const float*)(ws + WS_SX2), (const float*)(ws + WS_SWIN) + l * 4096};
            for (int rep = 0; rep <= REPK(2); ++rep) { pg8::gemm_phase<pg8::EpiB<1>, pg8::StaticOrder, true, false, true>(lds, g, S, E); __syncthreads(); }
        }
        SEAM(pb + 1);
        if (PHON(3) && IN(pb + 2)) {
            if (REPK(12)) qknorm_rope_phase(Qb, Kb, nullptr, a.q_norm_w + l * 128, a.k_norm_w + l * 128, (const f32x2*)(ws + WS_ROPE), gw, NGW, lane, (size_t)(WS_EIDX - WS_Q) / 2);
            qknorm_rope_phase(Qb, Kb, ws + WS_K8, a.q_norm_w + l * 128, a.k_norm_w + l * 128, (const f32x2*)(ws + WS_ROPE), gw, NGW, lane);
            for (int rep = 0; rep <= REPK(3); ++rep) poolwin_phase(UPb, Mb, gt, NGT);
            v8t_phase(Vb, ws + WS_V8T, (unsigned*)(ws + WS_CTL) + CW_VF + l, gw, NGW, lane);
            if (l == 0) wc8_phase((const bf16*)(ws + WS_WC), ws + WS_WC8, (float*)(ws + WS_SWC), gw, NGW, lane);
        }
        SEAM(pb + 2);
#ifndef GATHER_PROBE_ABL
#define GATHER_PROBE_ABL 0
#endif
#ifndef ATT_PROBE_ABL
#define ATT_PROBE_ABL 0
#endif
#define ATT_UNITS(NM, TO_SCRATCH, SEL, REDO) ATT_UNITS_(NM, TO_SCRATCH, 0, SEL, REDO)
#define ATT_UNITS_(NM, TO_SCRATCH, ABLV, SEL, REDO) do { for (int i = 0;; ++i) { int x, g, qb; \
            if (G == 256) { if (i >= 4) break; x = bid & 7; g = i; qb = bid >> 3; } else { const int u = bid + i * G; if (u >= 1024) break; x = u >> 7; g = (u & 127) >> 5; qb = u & 31; } \
            if (!(((SEL) >> (i & 31)) & 1u)) continue; \
            const int b = x >> 1, kvh = x & 1, h = kvh * 4 + g; bf16* q0 = Qb + ((size_t)(b * SEQ + qb * 256)) * 1024 + h * 128; \
            const bf16* k0 = (NM) ? (const bf16*)(ws + WS_K8 + ((size_t)b * SEQ) * 256 + kvh * 128) : Kb + ((size_t)b * SEQ) * 256 + kvh * 128; \
            const bf16* v0 = (NM) ? (const bf16*)(ws + WS_V8T + ((size_t)(b * (SEQ / 64)) * 2 + kvh) * 8192) : Vb + ((size_t)b * SEQ) * 256 + kvh * 128; \
            const bool ok_ = att::attn_dense_body3<att::bf16, NM, NM, ABLV>(q0, k0, v0, (TO_SCRATCH) ? (bf16*)(ws + WS_EIDX) + (q0 - Qb) : q0, SEQ, (char*)lds_raw, a.q_norm_w + l * 128, (const float*)(ws + WS_ROPE), qb * 256); \
            if (!ok_) (REDO) |= 1u << (i & 31); __syncthreads(); } } while (0)
#define ATT_ALL(TO_SCRATCH, ABLV) do { unsigned sel_ = 0xFFFFFFFFu, none_ = 0u; if (att_nomax) { unsigned redo_ = 0u; ATT_UNITS_(true, TO_SCRATCH, ABLV, 0xFFFFFFFFu, redo_); sel_ = redo_; } \
            if (sel_) ATT_UNITS_(false, TO_SCRATCH, 0, sel_, none_); } while (0)
        if (ATTN_CHECK || (PHON(4) && IN(pb + 3))) { float mq = 0.f, mk = 0.f;
            for (int i = 0; i < 128; ++i) { mq = fmaxf(mq, fabsf(a.q_norm_w[l * 128 + i])); mk = fmaxf(mk, fabsf(a.k_norm_w[l * 128 + i])); }
            att_nomax = (16.65f * mq * mk) < 100.f && mq < 128.f && mk < 32.f && (1024 + G - 1) / G <= 32;
            att_nomax = att_nomax && __hip_atomic_load((unsigned*)(ws + WS_CTL) + CW_VF + l, __ATOMIC_RELAXED, __HIP_MEMORY_SCOPE_AGENT) == 2u; }
#if ATTN_CHECK
        if (l == 0) {
            ATT_ALL(true, 0);
            xcd_barrier(bar);
            attn_check(Qb, Kb, Vb, (const bf16*)(ws + WS_EIDX), (unsigned*)(ws + WS_CTL) + CW_FLAG, lds, tid, bid, a.q_norm_w, (const f32x2*)(ws + WS_ROPE));
            xcd_barrier(bar);
        }
#endif
        if (PHON(4) && IN(pb + 3)) {
            if (REPK(4)) ATT_ALL(true, ATT_PROBE_ABL);
            ATT_ALL(false, 0);
        }
        SEAM(pb + 3);
        tid = threadIdx.x; asm volatile("" : "+v"(tid)); lane = tid & 63; wave = __builtin_amdgcn_readfirstlane(tid >> 6); gw = bid * NWAVES + wave; gt = bid * NTHR + tid;
#if REP_MASK & 0xE0
        if (IN(pb + 4)) {
            bf16* SCR = (bf16*)(ws + WS_EIDX);
            if (REPK(5)) { pg8::Gemm g{Qb, (const bf16*)(ws + WS_WAO) + (size_t)l * 1024 * 1024, TOK, DM, DM}; pg8::StaticOrder S; S.init(TOK, DM, G, bid);
              pg8::EpiB<0> E{SCR, 1024, nullptr, nullptr, nullptr, nullptr, nullptr, nullptr, nullptr, nullptr}; pg8::gemm_phase<pg8::EpiB<0>, pg8::StaticOrder, true, true>(lds, g, S, E); __syncthreads(); }
            if (REPK(5)) { pg8::Gemm g{Mb, (const bf16*)(ws + WS_WMIX) + (size_t)l * 512 * 512, TOK, POOLW, POOLW}; pg8::StaticOrder S; S.init(TOK, POOLW, G, bid);
              pg8::EpiB<0> E{SCR, 512, nullptr, nullptr, nullptr, nullptr, nullptr, nullptr, nullptr, nullptr}; pg8::gemm_phase<pg8::EpiB<0>, pg8::StaticOrder, true, true>(lds, g, S, E); __syncthreads(); }
            if (REPK(6)) { pg8::Gemm g{UPb, (const bf16*)(ws + WS_WPO) + (size_t)l * 1024 * 512, TOK, DM, POOLW}; pg8::StaticOrder S; S.init(TOK, DM, G, bid);
              pg8::EpiB<0> E{SCR, 1024, nullptr, nullptr, nullptr, nullptr, nullptr, nullptr, nullptr, nullptr}; pg8::gemm_phase<pg8::EpiB<0>, pg8::StaticOrder, true, true>(lds, g, S, E); __syncthreads(); }
            if (REPK(7)) { pg8::Gemm g{GPb, (const bf16*)(ws + WS_WOUT) + (size_t)l * 1024 * 1024, TOK, DM, DM}; pg8::StaticOrder S; S.init(TOK, DM, G, bid);
              pg8::EpiB<0> E{SCR, 1024, nullptr, nullptr, nullptr, nullptr, nullptr, nullptr, nullptr, nullptr}; pg8::gemm_phase<pg8::EpiB<0>, pg8::StaticOrder, true, true>(lds, g, S, E); __syncthreads(); }
        }
#endif
        if (PHON(5) && IN(pb + 4)) {
            { pg8::Gemm g{Qb, (const bf16*)(ws + WS_WAO) + (size_t)l * 1024 * 1024, TOK, DM, DM}; pg8::StaticOrder S; S.init(TOK, DM, G, bid);
              pg8::EpiB<2> E{GAb, 1024, nullptr, nullptr, nullptr, nullptr, nullptr, nullptr, nullptr, nullptr};
              pg8::gemm_phase<pg8::EpiB<2>, pg8::StaticOrder, true, true>(lds, g, S, E); }
            __syncthreads();
            { pg8::Gemm g{Mb, (const bf16*)(ws + WS_WPO) + (size_t)l * 1024 * 512, TOK, DM, POOLW}; pg8::StaticOrder S; S.init(TOK, DM, G, bid);
              pg8::EpiB<4> E{GPb, 1024, GAb, nullptr, nullptr, nullptr, nullptr, nullptr, nullptr, nullptr};
              pg8::gemm_phase<pg8::EpiB<4>, pg8::StaticOrder, true, true>(lds, g, S, E); }
        }
        SEAM(pb + 4);
        if (PHON(7) && IN(pb + 6)) {
            pg8::Gemm g{GPb, (const bf16*)(ws + WS_WOUT) + (size_t)l * 1024 * 1024, TOK, DM, DM}; pg8::StaticOrder S; S.init(TOK, DM, G, bid);
            pg8::EpiResid E{a.x, (bf16*)a.out, modl + 2048, (l == 0) ? 0 : 1};
            pg8::gemm_phase<pg8::EpiResid, pg8::StaticOrder, true, true>(lds, g, S, E);
        }
        SEAM(pb + 6);
        if (PHON(8) && IN(pb + 7)) for (int rep = 0; rep <= REPK(8); ++rep) normmod_phase<true>(a.out, a.norm_ffn_w + l * 1024, modl, 3072, 4096, nullptr  , gw, NGW, lane, (unsigned*)(ws + WS_XQ), (float*)(ws + WS_SX));
        SEAM(pb + 7);
        if (PHON(9) && IN(pb + 8)) {
            pg8::Gemm g{(const bf16*)(ws + WS_XQ), (const bf16*)(ws + WS_WC8 + (size_t)l * 2048 * 1024), TOK, 2048, DM / 2}; pg8::StaticOrder S; S.init(TOK, 2048, G, bid);
            pg8::EpiB<6> E{QPb, 2048, nullptr, nullptr, nullptr, nullptr, nullptr, nullptr, nullptr, nullptr, (const float*)(ws + WS_SX), (const float*)(ws + WS_SWC) + l * 2048};
            for (int rep = 0; rep <= REPK(9); ++rep) { pg8::gemm_phase<pg8::EpiB<6>, pg8::StaticOrder, true, false, true>(lds, g, S, E); __syncthreads(); }
            asm volatile("s_waitcnt vmcnt(0)" ::: "memory"); __syncthreads();
            for (int rep = 0; rep <= REPK(10); ++rep) topk_phase(QPb, EIDX, GSb, S, lane, wave);
        }
        SEAM(pb + 8);
        if (PHON(11) && IN(pb + 10)) {
            if (REPK(11)) gather_phase<true, GATHER_PROBE_ABL, true>(XN, EIDX, GSb, EUb + (size_t)l * NEXP * 1024, EVb + (size_t)l * NEXP * 1024, (bf16*)a.out, a.out, modl + 5120, a.final_norm_w, nullptr, ws + WS_XQ2, (float*)(ws + WS_SX2), lds, gw, NGW, wave, lane, 1, ws + WS_XQ, (const float*)(ws + WS_SX), (const float*)(ws + WS_SU) + (size_t)l * NEXP);
            if (l == 0) gather_phase<false>(XN, EIDX, GSb, EUb + (size_t)l * NEXP * 1024, EVb + (size_t)l * NEXP * 1024, (bf16*)a.out, a.out, modl + 5120, a.norm_mix_w + 1024, MOD + (size_t)4 * 6144, ws + WS_XQ2, (float*)(ws + WS_SX2), lds, gw, NGW, wave, lane, 1, ws + WS_XQ, (const float*)(ws + WS_SX), (const float*)(ws + WS_SU) + (size_t)l * NEXP);
            else gather_phase<true>(XN, EIDX, GSb, EUb + (size_t)l * NEXP * 1024, EVb + (size_t)l * NEXP * 1024, (bf16*)a.out, a.out, modl + 5120, a.final_norm_w, nullptr, ws + WS_XQ2, (float*)(ws + WS_SX2), lds, gw, NGW, wave, lane, 1, ws + WS_XQ, (const float*)(ws + WS_SX), (const float*)(ws + WS_SU) + (size_t)l * NEXP);
        }
        SEAM(pb + 10);
    }
#if ATTN_CHECK
    xcd_barrier(bar);
    if (__hip_atomic_load((unsigned*)(ws + WS_CTL) + CW_FLAG, __ATOMIC_RELAXED, __HIP_MEMORY_SCOPE_AGENT) != 0u)
        for (size_t i = (size_t)bid * NTHR + tid0; i < (size_t)TOK * DM / 4; i += NGT) ((f32x4*)a.out)[i] = f32x4{0.f, 0.f, 0.f, 0.f};
#endif
#undef IN
#undef SEAM
#undef modl
#undef MOD
#undef XN
#undef Qb
#undef Kb
#undef Vb
#undef UPb
#undef GAb
#undef GPb
#undef Mb
#undef QPb
#undef EIDX
#undef GSb
#undef EUb
#undef EVb
}

extern "C" void kernel_launch(void* const* d_in, const int* in_sizes, int n_in, void* d_out, int out_size, void* d_ws, size_t ws_size, hipStream_t stream) {
    static int grid = 0;
    if (grid == 0) {
        if (n_in != 19 || in_sizes[0] != TOK * DM || out_size != TOK * DM || ws_size < WS_END) {
            fprintf(stderr, "kernel_launch: unexpected shapes: n_in %d in0 %d out %d ws %zu (need %zu); nothing launched\n", n_in, n_in > 0 ? in_sizes[0] : -1, out_size, ws_size, (size_t)WS_END); grid = -1; return; }
        int dev = 0, cus = 0, per_cu = 0;
        if (hipGetDevice(&dev) != hipSuccess || hipDeviceGetAttribute(&cus, hipDeviceAttributeMultiprocessorCount, dev) != hipSuccess) { grid = -1; return; }
        if (hipFuncSetAttribute((const void*)mega, hipFuncAttributeMaxDynamicSharedMemorySize, LDS_BYTES) != hipSuccess) { fprintf(stderr, "kernel_launch: hipFuncSetAttribute failed\n"); grid = -1; return; }
        if (hipOccupancyMaxActiveBlocksPerMultiprocessor(&per_cu, (const void*)mega, NTHR, LDS_BYTES) != hipSuccess || per_cu < 1) {
            fprintf(stderr, "kernel_launch: occupancy query says %d blocks per CU; nothing launched\n", per_cu); (void)hipGetLastError(); grid = -1; return; }
        grid = cus;
    }
    if (grid < 0) return;
    (void)hipMemsetAsync((char*)d_ws + WS_CTL, 0, CTL_ZERO_BYTES, stream);
    Args a; memset(&a, 0, sizeof(a));
    const float** ap = (const float**)&a;
    for (int i = 0; i < 19; ++i) ap[i] = (const float*)d_in[i];
    a.out = (float*)d_out; a.ws = (unsigned char*)d_ws;
#if MK_ONE_LAUNCH
    a.ph_lo = 0; a.ph_hi = N_PHASES;
    hipLaunchKernelGGL(mega, dim3(grid), dim3(NTHR), LDS_BYTES, stream, a);
#else
    for (int p = 0; p < N_PHASES; ++p) {
        if (p == 1 + 11) continue;
        a.ph_lo = p; a.ph_hi = p + 1;
        hipLaunchKernelGGL(mega, dim3(grid), dim3(NTHR), LDS_BYTES, stream, a);
    }
#endif
    const hipError_t le = hipPeekAtLastError();
    if (le != hipSuccess) fprintf(stderr, "kernel_launch: launch failed: %s\n", hipGetErrorName(le));
}
```

```cpp
#include <hip/hip_runtime.h>
#include <cstdio>
#include <cstdint>
#include <cstring>

#ifndef MK_ONE_LAUNCH
#define MK_ONE_LAUNCH 1
#endif

constexpr int DM = 1024, NB = 4, SEQ = 8192, TOK = NB * SEQ, DEPTH = 2;
constexpr int HD = 128, NH = 8, NKV = 2, KVW = 256, POOLW = 512, INC = 4096;
constexpr int PH = 8, PQD = 512, SUBD = 256, NKEYS = 128, NEXP = 16384, TOPK = 16;
constexpr int NADA = 6;
constexpr float EPS = 1e-6f;

constexpr size_t MiB = 1u << 20;
constexpr size_t WS_CTL = 0, CTL_ZERO_BYTES = 128 * 1024;
constexpr size_t WS_MOD = 1 * MiB;
constexpr size_t WS_ROPE = WS_MOD + 256 * 1024;
constexpr size_t WS_WIN = 2 * MiB;
constexpr size_t WS_WAO = WS_WIN + 16 * MiB;
constexpr size_t WS_WPO = WS_WAO + 4 * MiB;
constexpr size_t WS_WOUT = WS_WPO + 2 * MiB;
constexpr size_t WS_WQ = WS_WOUT + 4 * MiB;
constexpr size_t WS_SUBK = WS_WQ + 16 * MiB;
constexpr size_t WS_WMIX = WS_SUBK + 2 * MiB;
constexpr size_t WS_EXPU = 48 * MiB;
constexpr size_t WS_EXPV = WS_EXPU + 32 * MiB;
constexpr size_t WS_XN = 112 * MiB;
constexpr size_t WS_PROJ = 176 * MiB;
constexpr size_t WS_Q = WS_PROJ, WS_K = WS_Q + 64 * MiB, WS_V = WS_K + 16 * MiB, WS_UP = WS_V + 16 * MiB, WS_GA = WS_UP + 32 * MiB, WS_GP = WS_GA + 64 * MiB;
constexpr size_t WS_EIDX = 432 * MiB;
constexpr size_t WS_GS = WS_EIDX + 16 * MiB;
constexpr size_t WS_XQ = WS_GS + 16 * MiB;
constexpr size_t WS_K8 = WS_XN + 32 * MiB;
constexpr size_t WS_V8T = WS_K8 + 8 * MiB;
constexpr size_t WS_SX = WS_XQ + 32 * MiB;
constexpr size_t WS_SU = WS_SX + 256 * 1024;
constexpr size_t WS_SX2 = WS_SX + 128 * 1024;
constexpr size_t WS_SWIN = WS_SU + 128 * 1024;
constexpr size_t WS_SWQ = WS_SWIN + 32 * 1024;
constexpr size_t WS_ABD = WS_PROJ;
constexpr size_t WS_WQB = WS_PROJ + 32 * MiB;
constexpr size_t WS_WC = WS_WQ;
constexpr size_t WS_WC8 = WS_WQ + 8 * MiB;
constexpr size_t WS_SWC = WS_SWQ;
constexpr size_t WS_Q8 = WS_EIDX;
constexpr size_t WS_XQ2 = WS_XN;
constexpr size_t WS_END = WS_SX + 1 * MiB;
static_assert(WS_WMIX + 1 * MiB <= WS_EXPU && WS_GP + 64 * MiB == WS_EIDX, "d_ws map");

namespace pg8 {
#define PG8_LAS __attribute__((address_space(3)))
typedef unsigned short bf16_t;
typedef short bf16x8 __attribute__((ext_vector_type(8)));
typedef float f32x4 __attribute__((ext_vector_type(4)));
typedef unsigned u32x4 __attribute__((ext_vector_type(4)));
typedef int i32x4_t __attribute__((ext_vector_type(4)));
constexpr int BM = 256, BK = 64, HALF = 128, HTB = HALF * BK * 2  , STAGE_BYTES = 8 * HTB, NXCD = 8, WGM = 8;

__host__ __device__ __forceinline__ int lds_byte(int r, int c) { const int st = (r >> 4) * 2 + (c >> 5), rr = r & 15, cc = c & 31, ob = rr * 64 + cc * 2; return st * 1024 + (ob ^ (((ob >> 9) & 1) << 5)); }
__host__ __device__ __forceinline__ void stage_rc(int b, int& R, int& C) { const int st = b / 1024, sb = b % 1024, swz = sb ^ (((sb >> 9) & 1) << 5); R = (st >> 1) * 16 + swz / 64; C = (st & 1) * 32 + (swz % 64) / 2; }
__host__ __device__ __forceinline__ int perm32(int rho) { const int n = rho >> 4, i = rho & 15; return 8 * (i >> 2) + 4 * n + (i & 3); }

struct Unit { int pm, pn; };
struct Gemm { const bf16_t* A; const bf16_t* Bt; int M, N, K; int KT, kshift; };

struct StaticOrder {
    int nM, nN, nwg, G, c;
    __host__ __device__ void init(int M, int N, int G_, int c_) { nM = M / BM; nN = N / BM; nwg = nM * nN; G = G_; c = c_; }
    __host__ __device__ bool next(int i, Unit& u) const {
        const long L = (long)i * G + c; if (L >= nwg) return false;
        int wgid = (int)L; { const int q = nwg / NXCD, r = nwg % NXCD, xcd = wgid % NXCD, off = wgid / NXCD; wgid = (xcd < r ? xcd * (q + 1) : r * (q + 1) + (xcd - r) * q) + off; }
        const int nig = WGM * nN, gid = wgid / nig, fm = gid * WGM, gsz = (nM - fm) < WGM ? (nM - fm) : WGM;
        u.pm = fm + ((wgid % nig) % gsz); u.pn = (wgid % nig) / gsz; return true;
    }
    __device__ __forceinline__ void a_ready(const Unit&) const {}
    __device__ __forceinline__ void done(const Unit&) const {}
};

__device__ __forceinline__ unsigned cvt_pk_bf16(float lo, float hi) { unsigned r; asm volatile("v_cvt_pk_bf16_f32 %0, %1, %2" : "=v"(r) : "v"(lo), "v"(hi)); return r; }
__device__ __forceinline__ float bflo(unsigned w) { return __builtin_bit_cast(float, w << 16); }
__device__ __forceinline__ float bfhi(unsigned w) { return __builtin_bit_cast(float, w & 0xffff0000u); }
__device__ __forceinline__ float sigm(float x) { return __builtin_amdgcn_rcpf(1.f + __expf(-x)); }

template <int MODE> struct EpiB {
    static constexpr bool PERM = true, AFTER_DRAIN = false;
    bf16_t* O; int ldc; const bf16_t* T1; const float* scale;
    bf16_t *pq, *pk, *pv, *pup, *pga, *pgp;
    const float *srow, *scol;
    __device__ __forceinline__ void operator()(const f32x4 (&acc)[2][2][4][2], const Unit& u, int wr, int wc, int fr, int fq) const {
        const int row0 = u.pm * BM + wr * 64 + fr; int colt = u.pn * BM; bf16_t* base = O; int ld = ldc;
        if (MODE == 1) {
            const int pn = u.pn;
            if (pn < 4) { base = pq; ld = 1024; colt = pn * 256; }
            else if (pn == 4) { base = pk; ld = 256; colt = 0; }
            else if (pn == 5) { base = pv; ld = 256; colt = 0; }
            else if (pn < 8) { base = pup; ld = 512; colt = (pn - 6) * 256; }
            else if (pn < 12) { base = pga; ld = 1024; colt = (pn - 8) * 256; }
            else { base = pgp; ld = 1024; colt = (pn - 12) * 256; }
        }
        const int col0 = colt + wc * 32 + 8 * fq;
        f32x4 sv[2][2];
        if (MODE == 1 || MODE == 5 || MODE == 6) {
#pragma unroll
            for (int bj = 0; bj < 2; ++bj)
#pragma unroll
                for (int n = 0; n < 2; ++n) sv[bj][n] = *(const f32x4*)(scol + u.pn * BM + wc * 32 + 8 * fq + bj * HALF + 4 * n);
        }
        if (MODE == 3) {
#pragma unroll
            for (int bj = 0; bj < 2; ++bj)
#pragma unroll
                for (int n = 0; n < 2; ++n) sv[bj][n] = *(const f32x4*)(scale + col0 + bj * HALF + 4 * n);
        }
#pragma unroll
        for (int ai = 0; ai < 2; ++ai)
#pragma unroll
            for (int m = 0; m < 4; ++m) {
                const size_t roff = (size_t)(row0 + ai * HALF + m * 16) * ld + col0;
#pragma unroll
                for (int bj = 0; bj < 2; ++bj) {
                    f32x4 v0 = acc[ai][bj][m][0], v1 = acc[ai][bj][m][1];
                    if (MODE == 1 || MODE == 5 || MODE == 6) { const float sr = srow[row0 + ai * HALF + m * 16]; const i32x4_t i0 = __builtin_bit_cast(i32x4_t, v0), i1 = __builtin_bit_cast(i32x4_t, v1);
                        v0 = f32x4{(float)i0[0], (float)i0[1], (float)i0[2], (float)i0[3]} * sv[bj][0] * sr; v1 = f32x4{(float)i1[0], (float)i1[1], (float)i1[2], (float)i1[3]} * sv[bj][1] * sr; }
                    bf16_t* p = base + roff + bj * HALF;
                    if (MODE == 5) { const int row = row0 + ai * HALF + m * 16, chunk = wc * 4 + fq + bj * 16; p = base + ((((size_t)(row >> 5) * 16 + u.pn) * 32 + chunk) * 32 + (row & 31)) * 8; }
                    if (MODE == 3) { v0 = v0 * sv[bj][0]; v1 = v1 * sv[bj][1]; }
                    if (MODE == 2 || MODE == 4) {
                        const unsigned long long gq = *(const unsigned long long*)((const unsigned char*)pga + roff + bj * HALF); const int glo = (int)(unsigned)gq, ghi = (int)(unsigned)(gq >> 32);
                        const auto g0 = __builtin_amdgcn_cvt_pk_f32_fp8(glo, false), g1 = __builtin_amdgcn_cvt_pk_f32_fp8(glo, true), g2 = __builtin_amdgcn_cvt_pk_f32_fp8(ghi, false), g3 = __builtin_amdgcn_cvt_pk_f32_fp8(ghi, true);
                        v0[0] *= sigm(g0[0]); v0[1] *= sigm(g0[1]); v0[2] *= sigm(g1[0]); v0[3] *= sigm(g1[1]); v1[0] *= sigm(g2[0]); v1[1] *= sigm(g2[1]); v1[2] *= sigm(g3[0]); v1[3] *= sigm(g3[1]);
                    }
                    if (MODE == 4) {
                        const unsigned long long tq = *(const unsigned long long*)((const unsigned char*)pq + roff + bj * HALF); const int tlo = (int)(unsigned)tq, thi = (int)(unsigned)(tq >> 32);
                        const auto t0 = __builtin_amdgcn_cvt_pk_f32_fp8(tlo, false), t1_ = __builtin_amdgcn_cvt_pk_f32_fp8(tlo, true), t2 = __builtin_amdgcn_cvt_pk_f32_fp8(thi, false), t3 = __builtin_amdgcn_cvt_pk_f32_fp8(thi, true);
                        v0[0] += t0[0]; v0[1] += t0[1]; v0[2] += t1_[0]; v0[3] += t1_[1]; v1[0] += t2[0]; v1[1] += t2[1]; v1[2] += t3[0]; v1[3] += t3[1];
                    }
                    if (MODE == 2) {
                        int w0 = __builtin_amdgcn_cvt_pk_fp8_f32(v0[0], v0[1], 0, false); w0 = __builtin_amdgcn_cvt_pk_fp8_f32(v0[2], v0[3], w0, true);
                        int w1 = __builtin_amdgcn_cvt_pk_fp8_f32(v1[0], v1[1], 0, false); w1 = __builtin_amdgcn_cvt_pk_fp8_f32(v1[2], v1[3], w1, true);
                        *(unsigned long long*)((unsigned char*)pq + roff + bj * HALF) = (unsigned long long)(unsigned)w0 | ((unsigned long long)(unsigned)w1 << 32); continue; }
                    if (MODE == 1) { if (u.pn < 4 || u.pn >= 8) {
                            int w0 = __builtin_amdgcn_cvt_pk_fp8_f32(v0[0], v0[1], 0, false); w0 = __builtin_amdgcn_cvt_pk_fp8_f32(v0[2], v0[3], w0, true);
                            int w1 = __builtin_amdgcn_cvt_pk_fp8_f32(v1[0], v1[1], 0, false); w1 = __builtin_amdgcn_cvt_pk_fp8_f32(v1[2], v1[3], w1, true);
                            *(unsigned long long*)((unsigned char*)base + roff + bj * HALF) = (unsigned long long)(unsigned)w0 | ((unsigned long long)(unsigned)w1 << 32); continue; } }
                    u32x4 w; w.x = cvt_pk_bf16(v0[0], v0[1]); w.y = cvt_pk_bf16(v0[2], v0[3]); w.z = cvt_pk_bf16(v1[0], v1[1]); w.w = cvt_pk_bf16(v1[2], v1[3]);
                    if (MODE == 6) {
                        const int row = row0 + ai * HALF + m * 16; bf16_t* q = base + ((((((size_t)(row >> 5) * 8 + u.pn) * 2 + bj) * 4 + wc) * 2) * 32 + (row & 31)) * 16 + 4 * fq;
                        *(unsigned long long*)q = (unsigned long long)w.x | ((unsigned long long)w.y << 32); *(unsigned long long*)(q + 512) = (unsigned long long)w.z | ((unsigned long long)w.w << 32); }
                    else *(u32x4*)p = w;
                }
            }
    }
};

struct EpiResid {
    static constexpr bool PERM = false, AFTER_DRAIN = false;
    const float* Xin; bf16_t* XS; const float* gate; int xin_bf;
    __device__ __forceinline__ void operator()(const f32x4 (&acc)[2][2][4][2], const Unit& u, int wr, int wc, int fr, int fq) const {
        const int row0 = u.pm * BM + wr * 64 + fr, colb = u.pn * BM + wc * 32 + 4 * fq;
        const float* gp = gate + (size_t)((u.pm * BM) >> 13) * 6144;
        f32x4 gv[2][2];
#pragma unroll
        for (int bj = 0; bj < 2; ++bj)
#pragma unroll
            for (int n = 0; n < 2; ++n) gv[bj][n] = *(const f32x4*)(gp + colb + bj * HALF + 16 * n);
#pragma unroll
        for (int ai = 0; ai < 2; ++ai)
#pragma unroll
            for (int m = 0; m < 4; ++m) {
                const size_t row = (size_t)(row0 + ai * HALF + m * 16);
#pragma unroll
                for (int bj = 0; bj < 2; ++bj)
#pragma unroll
                    for (int n = 0; n < 2; ++n) { const int col = colb + bj * HALF + 16 * n;
                        bf16_t* sp = XS + row * 2048 + 1024 + col;
                        f32x4 xi;
                        if (xin_bf) { const unsigned long long raw = *(const unsigned long long*)sp; const unsigned lo = (unsigned)raw, hi = (unsigned)(raw >> 32); xi = f32x4{bflo(lo), bfhi(lo), bflo(hi), bfhi(hi)}; }
                        else xi = *(const f32x4*)(Xin + row * 1024 + col);
                        const f32x4 y = xi + gv[bj][n] * acc[ai][bj][m][n];
                        *(unsigned long long*)sp = (unsigned long long)cvt_pk_bf16(y[0], y[1]) | ((unsigned long long)cvt_pk_bf16(y[2], y[3]) << 32); }
            }
    }
};

template <class Epi, class Sched, bool ALIGN_EPI = false, bool SP2 = false, bool I8 = false>
__device__ __forceinline__ void gemm_phase(PG8_LAS unsigned char* lds, const Gemm g, const Sched& S, const Epi& E) {
    int tid = threadIdx.x; asm volatile("" : "+v"(tid));
    const int wid = __builtin_amdgcn_readfirstlane(tid >> 6), lane = tid & 63, wr = wid >> 2, wc = wid & 3, fr = lane & 15, fq = lane >> 4;
    const int K = g.K, nt = g.KT ? g.KT : K / BK;
    unsigned voffA[2], voffB[2];
#pragma unroll
    for (int i = 0; i < 2; ++i) { int R, C; stage_rc(tid * 16 + i * 8192, R, C); const int Rb = Epi::PERM ? ((R & ~31) + perm32(R & 31)) : R;
        voffA[i] = (unsigned)(R * K + C) * 2u; voffB[i] = (unsigned)(Rb * K + C) * 2u; }
    const size_t kstep = (size_t)(BK * 2);
    const size_t hstep = (size_t)HALF * K * 2;
    const size_t tstep = 2 * hstep;
    const unsigned ldsw = (unsigned)wid * 1024u;
    const int aoff = lds_byte(wr * 64 + fr, fq * 8), boff = lds_byte(wc * 32 + fr, fq * 8);
#define PG8_SA(b, h) (((b) * 2 + (h)) * HTB)
#define PG8_SB(b, h) ((4 + (b) * 2 + (h)) * HTB)
#define PG8_STAGE(bufoff, gbase, voff) do { _Pragma("unroll") for (int _i = 0; _i < 2; ++_i) \
        __builtin_amdgcn_global_load_lds((const unsigned*)((const char*)(gbase) + (voff)[_i]), (PG8_LAS unsigned*)(lds + (bufoff) + ldsw + _i * 8192), 16, 0, 0); } while (0)
#define PG8_LDA(dst, b, h) do { _Pragma("unroll") for (int m = 0; m < 4; ++m) _Pragma("unroll") for (int k = 0; k < 2; ++k) dst[m][k] = *(const PG8_LAS bf16x8*)(lds + PG8_SA(b, h) + aoff + m * 2048 + k * 1024); } while (0)
#define PG8_LDB(dst, b, h) do { _Pragma("unroll") for (int n = 0; n < 2; ++n) _Pragma("unroll") for (int k = 0; k < 2; ++k) dst[n][k] = *(const PG8_LAS bf16x8*)(lds + PG8_SB(b, h) + boff + n * 2048 + k * 1024); } while (0)
#define PG8_MMA(ai, bj, At, Bt) do { __builtin_amdgcn_s_setprio(1); _Pragma("unroll") for (int m = 0; m < 4; ++m) _Pragma("unroll") for (int n = 0; n < 2; ++n) _Pragma("unroll") for (int k = 0; k < 2; ++k) \
        { if constexpr (I8) acc[ai][bj][m][n] = __builtin_bit_cast(f32x4, __builtin_amdgcn_mfma_i32_16x16x64_i8(__builtin_bit_cast(i32x4_t, Bt[n][k]), __builtin_bit_cast(i32x4_t, At[m][k]), __builtin_bit_cast(i32x4_t, acc[ai][bj][m][n]), 0, 0, 0)); \
          else acc[ai][bj][m][n] = __builtin_amdgcn_mfma_f32_16x16x32_bf16(Bt[n][k], At[m][k], acc[ai][bj][m][n], 0, 0, 0); } __builtin_amdgcn_s_setprio(0); } while (0)
#define PG8_WAIT_V(n) asm volatile("s_waitcnt vmcnt(" #n ")" ::: "memory")
#define PG8_WAIT_L(n) asm volatile("s_waitcnt lgkmcnt(" #n ")" ::: "memory")
#define PG8_BAR __builtin_amdgcn_s_barrier()
#define PG8_SCHED __builtin_amdgcn_sched_barrier(0)
    Unit cur, nxt; int ui = 0;
    if (!S.next(0, cur)) return;
    f32x4 acc[2][2][4][2];
#pragma unroll
    for (int a = 0; a < 2; ++a)
#pragma unroll
        for (int b = 0; b < 2; ++b)
#pragma unroll
            for (int m = 0; m < 4; ++m)
#pragma unroll
                for (int n = 0; n < 2; ++n) acc[a][b][m][n] = (f32x4){0.f, 0.f, 0.f, 0.f};
    bf16x8 At[4][2], B0[2][2], B1[2][2];
    const char* cA = (const char*)g.A + (size_t)cur.pm * tstep + (size_t)cur.pm * g.kshift; const char* cB = (const char*)g.Bt + (size_t)cur.pn * tstep + (size_t)cur.pm * g.kshift;
    S.a_ready(cur);
    if constexpr (SP2) {
        PG8_STAGE(PG8_SB(0, 0), cB, voffB); PG8_STAGE(PG8_SB(0, 1), cB + hstep, voffB); PG8_STAGE(PG8_SA(0, 0), cA, voffA); PG8_STAGE(PG8_SA(0, 1), cA + hstep, voffA);
        if (wr == 1) PG8_BAR;
        PG8_WAIT_V(2); PG8_BAR;
        PG8_STAGE(PG8_SB(1, 0), cB + kstep, voffB); PG8_STAGE(PG8_SA(1, 0), cA + kstep, voffA); PG8_STAGE(PG8_SB(1, 1), cB + hstep + kstep, voffB);
        PG8_WAIT_V(6); PG8_BAR;
    } else {
        PG8_STAGE(PG8_SB(0, 0), cB, voffB); PG8_STAGE(PG8_SA(0, 0), cA, voffA); PG8_STAGE(PG8_SB(0, 1), cB + hstep, voffB); PG8_STAGE(PG8_SA(0, 1), cA + hstep, voffA);
        if (wr == 1) PG8_BAR;
        PG8_WAIT_V(4); PG8_BAR;
        PG8_STAGE(PG8_SB(1, 0), cB + kstep, voffB); PG8_STAGE(PG8_SA(1, 0), cA + kstep, voffA); PG8_STAGE(PG8_SB(1, 1), cB + hstep + kstep, voffB);
        PG8_WAIT_V(6); PG8_BAR;
    }
    for (;;) {
        const bool has_next = S.next(ui + 1, nxt);
        const char* nA = has_next ? (const char*)g.A + (size_t)nxt.pm * tstep + (size_t)nxt.pm * g.kshift : cA; const char* nB = has_next ? (const char*)g.Bt + (size_t)nxt.pn * tstep + (size_t)nxt.pm * g.kshift : cB;
        for (int t = 0; t < nt; t += 2) {
            const bool last = (t == nt - 2);
            const char* a1 = cA + (size_t)(t + 1) * kstep;
            const char* a2 = last ? nA : cA + (size_t)(t + 2) * kstep; const char* b2 = last ? nB : cB + (size_t)(t + 2) * kstep;
            const char* a3 = a2 + kstep; const char* b3 = b2 + kstep;
            if (last && has_next) S.a_ready(nxt);
            if constexpr (SP2) {
            PG8_LDB(B0, 0, 0); PG8_LDB(B1, 0, 1); PG8_SCHED; PG8_LDA(At, 0, 0); PG8_STAGE(PG8_SA(1, 1), a1 + hstep, voffA);
            PG8_WAIT_V(8); PG8_WAIT_L(0); PG8_BAR; PG8_MMA(0, 0, At, B0); PG8_MMA(0, 1, At, B1); PG8_BAR; PG8_SCHED;
            PG8_LDA(At, 0, 1); PG8_STAGE(PG8_SB(0, 0), b2, voffB); PG8_STAGE(PG8_SB(0, 1), b2 + hstep, voffB); PG8_STAGE(PG8_SA(0, 0), a2, voffA);
            PG8_WAIT_V(8); PG8_WAIT_L(0); PG8_BAR; PG8_MMA(1, 0, At, B0); PG8_MMA(1, 1, At, B1); PG8_BAR; PG8_SCHED;
            PG8_LDB(B0, 1, 0); PG8_LDB(B1, 1, 1); PG8_SCHED; PG8_LDA(At, 1, 0); PG8_STAGE(PG8_SA(0, 1), a2 + hstep, voffA);
            PG8_WAIT_V(8); PG8_WAIT_L(0); PG8_BAR; PG8_MMA(0, 0, At, B0); PG8_MMA(0, 1, At, B1); PG8_BAR; PG8_SCHED;
            PG8_LDA(At, 1, 1); PG8_STAGE(PG8_SB(1, 0), b3, voffB); PG8_STAGE(PG8_SB(1, 1), b3 + hstep, voffB); PG8_STAGE(PG8_SA(1, 0), a3, voffA);
            PG8_WAIT_V(8); PG8_WAIT_L(0); PG8_BAR; PG8_MMA(1, 0, At, B0); PG8_MMA(1, 1, At, B1); PG8_BAR; PG8_SCHED;
            } else {
            PG8_LDB(B0, 0, 0); PG8_SCHED; PG8_LDA(At, 0, 0); PG8_STAGE(PG8_SA(1, 1), a1 + hstep, voffA);
            PG8_WAIT_L(8); PG8_BAR; PG8_WAIT_L(0); PG8_MMA(0, 0, At, B0); PG8_BAR; PG8_SCHED;
            PG8_LDB(B1, 0, 1); PG8_STAGE(PG8_SB(0, 0), b2, voffB);
            PG8_BAR; PG8_WAIT_L(0); PG8_MMA(0, 1, At, B1); PG8_BAR;
            PG8_LDA(At, 0, 1); PG8_STAGE(PG8_SA(0, 0), a2, voffA);
            PG8_BAR; PG8_WAIT_L(0); PG8_MMA(1, 0, At, B0); PG8_BAR; PG8_SCHED;
            PG8_STAGE(PG8_SB(0, 1), b2 + hstep, voffB);
            PG8_WAIT_V(6); PG8_BAR; PG8_MMA(1, 1, At, B1); PG8_BAR;
            PG8_LDB(B0, 1, 0); PG8_SCHED; PG8_LDA(At, 1, 0); PG8_STAGE(PG8_SA(0, 1), a2 + hstep, voffA);
            PG8_WAIT_L(8); PG8_BAR; PG8_WAIT_L(0); PG8_MMA(0, 0, At, B0); PG8_BAR; PG8_SCHED;
            PG8_LDB(B1, 1, 1); PG8_STAGE(PG8_SB(1, 0), b3, voffB);
            PG8_BAR; PG8_WAIT_L(0); PG8_MMA(0, 1, At, B1); PG8_BAR;
            PG8_LDA(At, 1, 1); PG8_STAGE(PG8_SA(1, 0), a3, voffA);
            PG8_BAR; PG8_WAIT_L(0); PG8_MMA(1, 0, At, B0); PG8_BAR; PG8_SCHED;
            PG8_STAGE(PG8_SB(1, 1), b3 + hstep, voffB);
            PG8_WAIT_V(6); PG8_BAR; PG8_MMA(1, 1, At, B1); PG8_BAR;
            }
        }
        if constexpr (ALIGN_EPI) { if (wr == 0) PG8_BAR; }
        if constexpr (!Epi::AFTER_DRAIN) { E(acc, cur, wr, wc, fr, fq); S.done(cur); }
        if (!has_next) break;
#pragma unroll
        for (int a = 0; a < 2; ++a)
#pragma unroll
            for (int b = 0; b < 2; ++b)
#pragma unroll
                for (int m = 0; m < 4; ++m)
#pragma unroll
                    for (int n = 0; n < 2; ++n) acc[a][b][m][n] = (f32x4){0.f, 0.f, 0.f, 0.f};
        cur = nxt; cA = nA; cB = nB; ++ui;
        if constexpr (ALIGN_EPI) { if (wr == 1) PG8_BAR; }
    }
    PG8_WAIT_V(0);
    if constexpr (!ALIGN_EPI) { if (wr == 0) PG8_BAR; }
    PG8_BAR;
    if constexpr (Epi::AFTER_DRAIN) { E.fused(acc, cur, wr, wc, fr, fq, lds, wid, lane); S.done(cur); }
#undef PG8_SA
#undef PG8_SB
#undef PG8_STAGE
#undef PG8_LDA
#undef PG8_LDB
#undef PG8_MMA
#undef PG8_WAIT_V
#undef PG8_WAIT_L
#undef PG8_BAR
#undef PG8_SCHED
}
}
namespace att {
typedef unsigned short bf16;
constexpr int   D = 128, NW = 8, QBLK = 32, KVBLK = 64;
constexpr float SCALE = 0.088388347648318440f;
constexpr float THR = 8.f;
constexpr int SDEPTH = 1;
constexpr int LDQ = 1024, LDK = 256, LDO = 1024;
constexpr size_t SHM_V = KVBLK * D * 2, SHM_K = KVBLK * D * 2, SHM_ATTN = 3 * SHM_V + 3 * SHM_K + NW * 64 * 4;
using bf16x8 = __attribute__((ext_vector_type(8))) short;
using s16x4  = __attribute__((ext_vector_type(4))) short;
using f32x16 = __attribute__((ext_vector_type(16))) float;
using f32x8  = __attribute__((ext_vector_type(8))) float;
using u32x4  = __attribute__((ext_vector_type(4))) unsigned;
using i32x8  = __attribute__((ext_vector_type(8))) int;
constexpr size_t SHM_K8 = KVBLK * D;
#define KSWZ8(row, colB) ((row) * 128 + ((colB) ^ ((((row) >> 1) & 7) << 4)))
constexpr size_t SHM_V8 = KVBLK * D;
#define V8SWZ(d, colB) ((d) * 64 + ((colB) ^ ((((d) >> 2) & 3) << 4)))
#define KSWZ(row, colB) ((row) * 256 + ((colB) ^ (((row) & 15) << 4)))
#define SBAR() __builtin_amdgcn_sched_barrier(0)
#define ATT_LAS __attribute__((address_space(3)))
__device__ __forceinline__ int crow(int r, int hi) { return (r & 3) + 8 * (r >> 2) + 4 * hi; }
__device__ __forceinline__ unsigned cvtpk(float lo, float hi) {
  unsigned r; asm volatile("v_cvt_pk_bf16_f32 %0, %1, %2" : "=v"(r) : "v"(lo), "v"(hi)); return r;
}
template <typename TIn> struct Stage;
template <> struct Stage<bf16>  { using T = bf16x8;
  __device__ static __forceinline__ T ld8(const bf16* p) { return *reinterpret_cast<const bf16x8*>(p); }
  __device__ static __forceinline__ bf16x8 tobf(T x) { return x; } };

__device__ __forceinline__ void partialSM(f32x16& p0, f32x16& p1, float& m_reg, float& mn, float& alpha) {
  constexpr float C = 1.0f;
  float pmax = p0[0]; for (int r = 1; r < 16; ++r) pmax = fmaxf(pmax, p0[r]); for (int r = 0; r < 16; ++r) pmax = fmaxf(pmax, p1[r]);
  { auto rr = __builtin_amdgcn_permlane32_swap(__float_as_uint(pmax), __float_as_uint(pmax), false, false);
    pmax = fmaxf(__uint_as_float(rr[0]), __uint_as_float(rr[1])); }
  if (__builtin_expect(__all(pmax - m_reg <= THR * 1.4426950408889634f), 1)) { mn = m_reg; alpha = 1.f; }
  else { mn = fmaxf(m_reg, pmax); alpha = __builtin_amdgcn_exp2f((m_reg - mn) * C); m_reg = mn; }
  float mnC = -mn * C;
  for (int r = 0; r < 16; ++r) p0[r] = fmaf(p0[r], C, mnC); for (int r = 0; r < 16; ++r) p1[r] = fmaf(p1[r], C, mnC);
  for (int r = 0; r < 16; ++r) p0[r] = __builtin_amdgcn_exp2f(p0[r]);
}
__device__ __forceinline__ void finishSM(f32x16& p0, f32x16& p1, float alpha, float& l_reg, bf16x8& pa0, bf16x8& pa1, bf16x8& pa2, bf16x8& pa3) {
  for (int r = 0; r < 16; ++r) p1[r] = __builtin_amdgcn_exp2f(p1[r]);
  float ps = 0; for (int r = 0; r < 16; ++r) ps += p0[r]; for (int r = 0; r < 16; ++r) ps += p1[r];
  { auto rr = __builtin_amdgcn_permlane32_swap(__float_as_uint(ps), __float_as_uint(ps), false, false);
    ps = __uint_as_float(rr[0]) + __uint_as_float(rr[1]); }
  l_reg = l_reg * alpha + ps;
#define PK4(P, BASE, OUT) do { unsigned a0 = cvtpk(P[BASE + 0], P[BASE + 1]), a1 = cvtpk(P[BASE + 2], P[BASE + 3]);   \
    unsigned b0 = cvtpk(P[BASE + 4], P[BASE + 5]), b1 = cvtpk(P[BASE + 6], P[BASE + 7]);                              \
    auto r0 = __builtin_amdgcn_permlane32_swap(a0, b0, false, false); auto r1 = __builtin_amdgcn_permlane32_swap(a1, b1, false, false); \
    u32x4 w = {r0[0], r1[0], r0[1], r1[1]}; OUT = *reinterpret_cast<bf16x8*>(&w); } while (0)
  PK4(p0, 0, pa0); PK4(p0, 8, pa1); PK4(p1, 0, pa2); PK4(p1, 8, pa3);
#undef PK4
}
template <int ABL> __device__ __forceinline__ void partialSM_nm(f32x16& p0, f32x16& p1) { asm volatile("" : "+v"(p0), "+v"(p1));
  for (int r = 0; r < 16; ++r) p0[r] = (ABL & 2) ? fmaf(p0[r], p0[r], 1.f) : __builtin_amdgcn_exp2f(p0[r]); asm volatile("" : "+v"(p0), "+v"(p1)); }
template <int ABL> __device__ __forceinline__ void finishSM_nm(f32x16& p0, f32x16& p1, float& l_reg, bf16x8& pa0, bf16x8& pa1, bf16x8& pa2, bf16x8& pa3) {
  for (int r = 0; r < 16; ++r) p1[r] = (ABL & 2) ? fmaf(p1[r], p1[r], 1.f) : __builtin_amdgcn_exp2f(p1[r]);
  float ps = 0; for (int r = 0; r < 16; ++r) ps += p0[r]; for (int r = 0; r < 16; ++r) ps += p1[r];
  l_reg += ps; SBAR();
#define PK4(P, BASE, OUT) do { unsigned a0 = cvtpk(P[BASE + 0], P[BASE + 1]), a1 = cvtpk(P[BASE + 2], P[BASE + 3]);   \
    unsigned b0 = cvtpk(P[BASE + 4], P[BASE + 5]), b1 = cvtpk(P[BASE + 6], P[BASE + 7]);                              \
    auto r0 = __builtin_amdgcn_permlane32_swap(a0, b0, false, false); auto r1 = __builtin_amdgcn_permlane32_swap(a1, b1, false, false); \
    u32x4 w = {r0[0], r1[0], r0[1], r1[1]}; OUT = *reinterpret_cast<bf16x8*>(&w); } while (0)
  PK4(p0, 0, pa0); PK4(p0, 8, pa1); PK4(p1, 0, pa2); PK4(p1, 8, pa3);
#undef PK4
}
template <int ABL = 0> __device__ __forceinline__ void qkt(f32x16& p0, f32x16& p1, const bf16* Ks, const bf16x8* qr, int r32, int hi) {
  p0 = f32x16{}; p1 = f32x16{};
  for (int d0 = 0; d0 < 8; ++d0) { int cb = (((ABL & 16) ? 0 : d0) * 16 + hi * 8) * 2;
    bf16x8 b0, b1;
    if (ABL & 128) { b0 = qr[d0]; b1 = qr[d0 ^ 1]; } else {
    b0 = *reinterpret_cast<const bf16x8*>((const char*)Ks + KSWZ(r32, cb));
    b1 = *reinterpret_cast<const bf16x8*>((const char*)Ks + KSWZ(32 + r32, cb)); }
    if (ABL & 32) { asm volatile("" :: "v"(b0), "v"(b1)); continue; }
    p0 = __builtin_amdgcn_mfma_f32_32x32x16_bf16(b0, qr[d0], p0, 0, 0, 0);
    p1 = __builtin_amdgcn_mfma_f32_32x32x16_bf16(b1, qr[d0], p1, 0, 0, 0); }
}
template <int ABL = 0> __device__ __forceinline__ void qkt8(f32x16& p0, f32x16& p1, const char* Ks, const i32x8* qf, int r32, int hi, const f32x16& cinit) {
  const int g4 = ((r32 >> 1) & 7) << 4;
  if (ABL & 32) { p0 = cinit; p1 = cinit; }
#pragma unroll
  for (int s = 0; s < 2; ++s) { const int c0 = (s * 64 + hi * 32) ^ g4, c1 = (s * 64 + hi * 32 + 16) ^ g4;
    u32x4 a0, a1, b0, b1;
    if (ABL & 128) { a0 = u32x4{(unsigned)qf[0][0], (unsigned)qf[0][1], (unsigned)qf[1][2], (unsigned)qf[1][3]}; a1 = a0; b0 = a0; b1 = a0; } else {
    a0 = *reinterpret_cast<const u32x4*>(Ks + r32 * 128 + c0); a1 = *reinterpret_cast<const u32x4*>(Ks + r32 * 128 + c1);
    b0 = *reinterpret_cast<const u32x4*>(Ks + (32 + r32) * 128 + c0); b1 = *reinterpret_cast<const u32x4*>(Ks + (32 + r32) * 128 + c1); }
    const i32x8 A = {(int)a0.x, (int)a0.y, (int)a0.z, (int)a0.w, (int)a1.x, (int)a1.y, (int)a1.z, (int)a1.w};
    const i32x8 B = {(int)b0.x, (int)b0.y, (int)b0.z, (int)b0.w, (int)b1.x, (int)b1.y, (int)b1.z, (int)b1.w};
    if (ABL & 32) { asm volatile("" :: "v"(A), "v"(B)); continue; }
    if (s == 0) { p0 = __builtin_amdgcn_mfma_scale_f32_32x32x64_f8f6f4(A, qf[s], cinit, 0, 0, 0, 0, 0, 0); p1 = __builtin_amdgcn_mfma_scale_f32_32x32x64_f8f6f4(B, qf[s], cinit, 0, 0, 0, 0, 0, 0); }
    else { p0 = __builtin_amdgcn_mfma_scale_f32_32x32x64_f8f6f4(A, qf[s], p0, 0, 0, 0, 0, 0, 0); p1 = __builtin_amdgcn_mfma_scale_f32_32x32x64_f8f6f4(B, qf[s], p1, 0, 0, 0, 0, 0, 0); } }
}
template <int ABL = 0> __device__ __forceinline__ void finishSM_nm8(f32x16& p0, f32x16& p1, float& l_reg, i32x8& pf) {
  for (int r = 0; r < 16; ++r) p1[r] = (ABL & 2) ? fmaf(p1[r], p1[r], 1.f) : __builtin_amdgcn_exp2f(p1[r]);
  float ps = 0; for (int r = 0; r < 16; ++r) ps += p0[r]; for (int r = 0; r < 16; ++r) ps += p1[r];
  l_reg += ps; SBAR();
#pragma unroll
  for (int k = 0; k < 4; ++k) { int w = __builtin_amdgcn_cvt_pk_bf8_f32(p0[4 * k], p0[4 * k + 1], 0, false); w = __builtin_amdgcn_cvt_pk_bf8_f32(p0[4 * k + 2], p0[4 * k + 3], w, true); pf[k] = w;
    int v = __builtin_amdgcn_cvt_pk_bf8_f32(p1[4 * k], p1[4 * k + 1], 0, false); v = __builtin_amdgcn_cvt_pk_bf8_f32(p1[4 * k + 2], p1[4 * k + 3], v, true); pf[4 + k] = v; }
}
__device__ __forceinline__ void finish8a(f32x16& p0, f32x16& p1, i32x8& pf) {
#pragma unroll
  for (int r = 0; r < 16; ++r) p1[r] = __builtin_amdgcn_exp2f(p1[r]);
#pragma unroll
  for (int k = 0; k < 4; ++k) { int w = __builtin_amdgcn_cvt_pk_bf8_f32(p0[4 * k], p0[4 * k + 1], 0, false); w = __builtin_amdgcn_cvt_pk_bf8_f32(p0[4 * k + 2], p0[4 * k + 3], w, true); pf[k] = w;
    int v = __builtin_amdgcn_cvt_pk_bf8_f32(p1[4 * k], p1[4 * k + 1], 0, false); v = __builtin_amdgcn_cvt_pk_bf8_f32(p1[4 * k + 2], p1[4 * k + 3], v, true); pf[4 + k] = v; }
}
__device__ __forceinline__ void finish8b(const f32x16& p0, const f32x16& p1, float& l_reg) {
  float s0 = 0.f, s1 = 0.f;
#pragma unroll
  for (int r = 0; r < 16; ++r) { s0 += p0[r]; s1 += p1[r]; }
  l_reg += s0 + s1;
}
__device__ __forceinline__ void partial8(f32x16& p0) {
#pragma unroll
  for (int r = 0; r < 16; ++r) p0[r] = __builtin_amdgcn_exp2f(p0[r]);
}
template <int ABL = 0> __device__ __forceinline__ void pv8(f32x16* o, const char* Vs, const i32x8& pf, int r32, int hi) {
  const int g = ((r32 >> 2) & 3) << 4, c0 = (hi * 32) ^ g, c1 = (hi * 32 + 16) ^ g;
#pragma unroll
  for (int d0 = 0; d0 < 4; ++d0) { const char* rp = Vs + (d0 * 32 + r32) * 64;
    u32x4 a0, a1; if (ABL & 64) { a0 = u32x4{(unsigned)pf[0], (unsigned)pf[1], (unsigned)pf[2], (unsigned)pf[3]}; a1 = a0; } else { a0 = *reinterpret_cast<const u32x4*>(rp + c0); a1 = *reinterpret_cast<const u32x4*>(rp + c1); }
    const i32x8 Vf = {(int)a0.x, (int)a0.y, (int)a0.z, (int)a0.w, (int)a1.x, (int)a1.y, (int)a1.z, (int)a1.w};
    if (ABL & 1) { asm volatile("" :: "v"(Vf), "v"(pf)); continue; }
    o[d0] = __builtin_amdgcn_mfma_scale_f32_32x32x64_f8f6f4(pf, Vf, o[d0], 1, 0, 0, 0, 0, 0); }
}
__device__ __forceinline__ int v_st(int k, int c) { const int kk = (k & ~0xC) | ((k & 4) << 1) | ((k & 8) >> 1); return ((kk >> 3) * 4 + (c >> 5)) * 512 + ((kk & 7) * 32 + (c & 31)) * 2; }
__device__ __forceinline__ int v_rd_base(int lane) { return ((lane & 3) << 3) | (((lane >> 2) & 3) << 6) | (((lane >> 4) & 1) << 5) | (((lane >> 5) & 1) << 8); }
constexpr int v_rd_off(int d0, int ks, int half) { return d0 * 512 + ks * 4096 + half * 2048; }
template <int OFF> __device__ __forceinline__ s16x4 tr_read(int vb) {
  s16x4 r; asm volatile("ds_read_b64_tr_b16 %0, %1 offset:%2" : "=&v"(r) : "v"(vb), "i"(OFF) : "memory"); return r;
}
template <int D0, int ABL = 0> __device__ __forceinline__ void pv_one(f32x16& od, int vb, bf16x8 pa0, bf16x8 pa1, bf16x8 pa2, bf16x8 pa3) {
  if (ABL & 64) { const s16x4 z = {0, 0, 0, 0}; const bf16x8 zz = {z[0], z[1], z[2], z[3], z[0], z[1], z[2], z[3]}; if (!(ABL & 1)) { od = __builtin_amdgcn_mfma_f32_32x32x16_bf16(pa0, zz, od, 0, 0, 0); od = __builtin_amdgcn_mfma_f32_32x32x16_bf16(pa1, zz, od, 0, 0, 0); od = __builtin_amdgcn_mfma_f32_32x32x16_bf16(pa2, zz, od, 0, 0, 0); od = __builtin_amdgcn_mfma_f32_32x32x16_bf16(pa3, zz, od, 0, 0, 0); } return; }
  const s16x4 l0 = tr_read<v_rd_off(D0, 0, 0)>(vb), h0 = tr_read<v_rd_off(D0, 0, 1)>(vb), l1 = tr_read<v_rd_off(D0, 1, 0)>(vb), h1 = tr_read<v_rd_off(D0, 1, 1)>(vb);
  const s16x4 l2 = tr_read<v_rd_off(D0, 2, 0)>(vb), h2 = tr_read<v_rd_off(D0, 2, 1)>(vb), l3 = tr_read<v_rd_off(D0, 3, 0)>(vb), h3 = tr_read<v_rd_off(D0, 3, 1)>(vb);
  asm volatile("s_waitcnt lgkmcnt(0)" ::: "memory"); SBAR();
#define PK(L, H) (bf16x8){L[0], L[1], L[2], L[3], H[0], H[1], H[2], H[3]}
  if (ABL & 1) { asm volatile("" :: "v"(l0), "v"(h0), "v"(l1), "v"(h1), "v"(l2), "v"(h2), "v"(l3), "v"(h3), "v"(pa0), "v"(pa1), "v"(pa2), "v"(pa3)); return; }
  od = __builtin_amdgcn_mfma_f32_32x32x16_bf16(pa0, PK(l0, h0), od, 0, 0, 0);
  od = __builtin_amdgcn_mfma_f32_32x32x16_bf16(pa1, PK(l1, h1), od, 0, 0, 0);
  od = __builtin_amdgcn_mfma_f32_32x32x16_bf16(pa2, PK(l2, h2), od, 0, 0, 0);
  od = __builtin_amdgcn_mfma_f32_32x32x16_bf16(pa3, PK(l3, h3), od, 0, 0, 0);
#undef PK
}
template <int ABL = 0> __device__ __forceinline__ void pv_d0(f32x16* o, int vb, bf16x8 pa0, bf16x8 pa1, bf16x8 pa2, bf16x8 pa3) {
  pv_one<0, ABL>(o[0], vb, pa0, pa1, pa2, pa3); pv_one<1, ABL>(o[1], vb, pa0, pa1, pa2, pa3); pv_one<2, ABL>(o[2], vb, pa0, pa1, pa2, pa3); pv_one<3, ABL>(o[3], vb, pa0, pa1, pa2, pa3);
}

template <typename TQ, bool NOMAX, bool K8, int ABL = 0>
__device__ __forceinline__ bool attn_dense_body3(const TQ* __restrict__ Qb, const bf16* __restrict__ Kh, const bf16* __restrict__ Vh,
                                                bf16* __restrict__ Ob, int seq, char* lds, const float* __restrict__ qw, const float* __restrict__ rope, int tpos0) {
  using St = Stage<bf16>; using SQ = Stage<bf16>;
  int tid = threadIdx.x; asm volatile("" : "+v"(tid));
  const int wid = tid >> 6, lane = tid & 63, r32 = lane & 31, hi = lane >> 5;
  bf16* V_lds = (bf16*)lds; bf16* K_lds = (bf16*)(lds + 3 * SHM_V);
  float* ws = (float*)(lds + 3 * SHM_V + 3 * SHM_K) + wid * 64; float* li_l = ws; float* al_l = ws + 32;
  float m_reg = -1e30f, l_reg = 0; f32x16 o[4] = {}; bf16x8 qr[8]; i32x8 qf[2];
  const TQ* Qw = Qb + (long)(wid * QBLK + r32) * LDQ + hi * 8;
  const int kr8_ = tid >> 3;
    const unsigned ksrc8 = (unsigned)(kr8_ * 256 + (((tid & 7) ^ ((kr8_ >> 1) & 7)) << 4));
    const unsigned vsrc8 = (unsigned)((tid >> 2) * 64 + (((tid & 3) ^ ((tid >> 4) & 3)) << 4));
    const unsigned kl0 = (unsigned)(uintptr_t)K_lds + (unsigned)wid * 1024u, vl0 = (unsigned)(uintptr_t)V_lds + (unsigned)wid * 1024u;
#define DMA8(T, B) do { const long k0_ = (long)(T) * KVBLK * 256; \
      __builtin_amdgcn_global_load_lds((const unsigned*)((const char*)Kh + k0_ + ksrc8), (ATT_LAS unsigned*)(uintptr_t)(kl0 + (unsigned)(B) * (unsigned)SHM_K8), 16, 0, 0); \
      __builtin_amdgcn_global_load_lds((const unsigned*)((const char*)Vh + k0_ + vsrc8), (ATT_LAS unsigned*)(uintptr_t)(vl0 + (unsigned)(B) * (unsigned)SHM_V8), 16, 0, 0); } while (0)
  if constexpr (K8) { DMA8(0, 0); DMA8(1, 1); DMA8(2, 2); }
  {
    float xq[8][8]; float ssq = 0.f;
#pragma unroll
    for (int d0 = 0; d0 < 8; ++d0) {
      if constexpr (sizeof(TQ) == 1) {
        const unsigned long long rq = *reinterpret_cast<const unsigned long long*>(Qw + d0 * 16); const int lo_ = (int)(unsigned)rq, hi_ = (int)(unsigned)(rq >> 32);
        const auto f0 = __builtin_amdgcn_cvt_pk_f32_fp8(lo_, false), f1 = __builtin_amdgcn_cvt_pk_f32_fp8(lo_, true), f2 = __builtin_amdgcn_cvt_pk_f32_fp8(hi_, false), f3 = __builtin_amdgcn_cvt_pk_f32_fp8(hi_, true);
        xq[d0][0] = f0[0]; xq[d0][1] = f0[1]; xq[d0][2] = f1[0]; xq[d0][3] = f1[1]; xq[d0][4] = f2[0]; xq[d0][5] = f2[1]; xq[d0][6] = f3[0]; xq[d0][7] = f3[1];
#pragma unroll
        for (int e = 0; e < 8; ++e) ssq += xq[d0][e] * xq[d0][e];
      } else { const bf16x8 raw = SQ::tobf(SQ::ld8(Qw + d0 * 16));
#pragma unroll
      for (int e = 0; e < 8; ++e) { const float v = __uint_as_float(((unsigned)(unsigned short)raw[e]) << 16); xq[d0][e] = v; ssq += v * v; } } }
    { unsigned a0 = __float_as_uint(ssq), a1 = a0; asm volatile("" : "+v"(a1));
      auto rr = __builtin_amdgcn_permlane32_swap(a0, a1, false, false); ssq = __uint_as_float(rr[0]) + __uint_as_float(rr[1]); }
    const float rstd = rsqrtf(ssq * (1.f / 128.f) + 1e-6f);
    const int tq = tpos0 + wid * QBLK + r32;
    const float qcs = SCALE * 1.4426950408889634f;
#pragma unroll
    for (int d0 = 0; d0 < 8; ++d0) { const float4 w0 = *reinterpret_cast<const float4*>(qw + d0 * 16 + hi * 8), w1 = *reinterpret_cast<const float4*>(qw + d0 * 16 + hi * 8 + 4);
      xq[d0][0] *= rstd * w0.x; xq[d0][1] *= rstd * w0.y; xq[d0][2] *= rstd * w0.z; xq[d0][3] *= rstd * w0.w; xq[d0][4] *= rstd * w1.x; xq[d0][5] *= rstd * w1.y; xq[d0][6] *= rstd * w1.z; xq[d0][7] *= rstd * w1.w; }
#pragma unroll
    for (int gp = 0; gp < 4; ++gp) { const int dl = (gp & 1) + (gp >> 1) * 4, dh = dl + 2;
      const int pos = (gp >> 1) ? 128 + (tq & 63) : (tq >> 6);
      const float2* cs = reinterpret_cast<const float2*>(rope) + pos * 32 + (gp & 1) * 16 + hi * 8;
#pragma unroll
      for (int e = 0; e < 8; ++e) { const float2 c2 = cs[e]; const float x1 = xq[dl][e], x2 = xq[dh][e]; xq[dl][e] = (x1 * c2.x - x2 * c2.y) * qcs; xq[dh][e] = (x2 * c2.x + x1 * c2.y) * qcs; } }
#pragma unroll
    for (int d0 = 0; d0 < 8; ++d0) {
      if constexpr (K8) { int w0 = __builtin_amdgcn_cvt_pk_fp8_f32(xq[d0][0], xq[d0][1], 0, false); w0 = __builtin_amdgcn_cvt_pk_fp8_f32(xq[d0][2], xq[d0][3], w0, true);
        int w1 = __builtin_amdgcn_cvt_pk_fp8_f32(xq[d0][4], xq[d0][5], 0, false); w1 = __builtin_amdgcn_cvt_pk_fp8_f32(xq[d0][6], xq[d0][7], w1, true);
        qf[d0 >> 2][(d0 & 3) * 2] = w0; qf[d0 >> 2][(d0 & 3) * 2 + 1] = w1; }
      else { u32x4 w = {cvtpk(xq[d0][0], xq[d0][1]), cvtpk(xq[d0][2], xq[d0][3]), cvtpk(xq[d0][4], xq[d0][5]), cvtpk(xq[d0][6], xq[d0][7])}; qr[d0] = *reinterpret_cast<bf16x8*>(&w); } }
  }
  const int sr = tid >> 4, sc = (tid & 15) * 8, vst0 = v_st(sr, sc), vst1 = v_st(32 + sr, sc);
  const int vb0 = (int)(uintptr_t)V_lds + v_rd_base(lane);
  struct { typename St::T vs0, vs1, ks0, ks1; } sr_[SDEPTH];
  const int kr8 = tid >> 3, kc8 = (tid & 7) * 16;
  const int v8st = V8SWZ(tid >> 2, (tid & 3) * 16);
#define SLOAD(i, k0) do { if constexpr (K8) { sr_[i].vs0 = *reinterpret_cast<const bf16x8*>((const char*)Vh + (long)(k0) * 256 + tid * 16); \
      sr_[i].ks0 = *reinterpret_cast<const bf16x8*>((const char*)Kh + (long)((k0) + kr8) * 256 + kc8); } \
    else { sr_[i].vs0 = St::ld8(&Vh[(long)((k0) + sr) * LDK + sc]); sr_[i].vs1 = St::ld8(&Vh[(long)((k0) + 32 + sr) * LDK + sc]); \
      sr_[i].ks0 = St::ld8(&Kh[(long)((k0) + sr) * LDK + sc]); sr_[i].ks1 = St::ld8(&Kh[(long)((k0) + 32 + sr) * LDK + sc]); } } while (0)
#define SWRITE(b, i) do { if constexpr (K8) { *(bf16x8*)((char*)V_lds + (b) * SHM_V8 + v8st) = sr_[i].vs0; *(bf16x8*)((char*)K_lds + (b) * SHM_K8 + KSWZ8(kr8, kc8)) = sr_[i].ks0; } \
    else { *(bf16x8*)((char*)V_lds + (b) * SHM_V + vst0) = St::tobf(sr_[i].vs0);          \
    *(bf16x8*)((char*)V_lds + (b) * SHM_V + vst1) = St::tobf(sr_[i].vs1); int kc = sc * 2;               \
    *(bf16x8*)((char*)K_lds + (b) * SHM_K + KSWZ(sr, kc)) = St::tobf(sr_[i].ks0);                       \
    *(bf16x8*)((char*)K_lds + (b) * SHM_K + KSWZ(32 + sr, kc)) = St::tobf(sr_[i].ks1); } } while (0)
#define QKT(P0, P1, B) do { if constexpr (K8) qkt8<ABL>(P0, P1, (const char*)K_lds + (B) * SHM_K8, qf, r32, hi, cneg); else qkt<ABL>(P0, P1, (bf16*)((char*)K_lds + (B) * SHM_K), qr, r32, hi); } while (0)
#define PVT(B) do { if constexpr (K8) pv8<ABL>(o, (const char*)V_lds + (B) * SHM_V8, pf, r32, hi); else pv_d0<ABL>(o, vb0 + (B) * (int)SHM_V, pa0, pa1, pa2, pa3); } while (0)
#define SWAIT() do { if constexpr (SDEPTH == 2) asm volatile("s_waitcnt vmcnt(4)" ::: "memory"); else asm volatile("s_waitcnt vmcnt(0)" ::: "memory"); } while (0)
#define RESC(a) do { if (__any((a) < 1.f)) { if (hi == 0) al_l[r32] = (a); asm volatile("s_waitcnt lgkmcnt(0)" ::: "memory"); \
    for (int d = 0; d < 4; ++d) for (int r = 0; r < 16; ++r) o[d][r] *= al_l[crow(r, hi)]; } } while (0)
#define PSM(p0, p1, mn, al) do { if constexpr (NOMAX) partialSM_nm<ABL>(p0, p1); else partialSM(p0, p1, m_reg, mn, al); } while (0)
#define FSM(p0, p1, al) do { if constexpr (K8) finishSM_nm8<ABL>(p0, p1, l_reg, pf); else if constexpr (NOMAX) finishSM_nm<ABL>(p0, p1, l_reg, pa0, pa1, pa2, pa3); else finishSM(p0, p1, al, l_reg, pa0, pa1, pa2, pa3); } while (0)
#define RSC(al) do { if constexpr (!NOMAX) RESC(al); } while (0)
  f32x16 pA0, pA1, pB0, pB1; float mnA = 0.f, mnB = 0.f, alA = 1.f, alB = 1.f; bf16x8 pa0, pa1, pa2, pa3; i32x8 pf; f32x16 cneg = {}; const int NT = seq / KVBLK;
  constexpr int SE = 0, SO = SDEPTH - 1;
  if constexpr (K8) {
#define BARV(N) do { if (ABL & 4) asm volatile("s_waitcnt vmcnt(" N ") lgkmcnt(0)" ::: "memory"); else asm volatile("s_waitcnt vmcnt(" N ") lgkmcnt(0)\n\ts_barrier" ::: "memory"); } while (0)
    BARV("4");
    QKT(pA0, pA1, 0);
    {
    float m = pA0[0];
#pragma unroll
    for (int r = 1; r < 16; ++r) m = fmaxf(m, pA0[r]);
#pragma unroll
    for (int r = 0; r < 16; ++r) m = fmaxf(m, pA1[r]);
    { unsigned a0 = __float_as_uint(m), a1 = a0; asm volatile("" : "+v"(a1));
      auto rr = __builtin_amdgcn_permlane32_swap(a0, a1, false, false); m = fmaxf(__uint_as_float(rr[0]), __uint_as_float(rr[1])); }
#pragma unroll
    for (int r = 0; r < 16; ++r) { cneg[r] = -m; pA0[r] -= m; pA1[r] -= m; }
  }
    PSM(pA0, pA1, mnA, alA);
    BARV("2");
#define SG(m, n) __builtin_amdgcn_sched_group_barrier(m, n, 0)
#define SCHED_R1() do { if (ABL == 0) { SG(0x100, 4); SG(0x008, 2); SG(0x100, 4); SG(0x400, 4); SG(0x002, 6); SG(0x400, 4); SG(0x002, 6); SG(0x008, 1); SG(0x400, 4); SG(0x002, 6); SG(0x008, 1); SG(0x400, 4); SG(0x002, 6); } } while (0)
#define SCHED_R2() do { if (ABL == 0) { SG(0x100, 2); _Pragma("unroll") for (int g_ = 0; g_ < 4; ++g_) { SG(0x008, 1); if (g_ < 3) SG(0x100, 2); SG(0x400, 4); SG(0x002, 8); } } } while (0)
    if (wid >= 4) __builtin_amdgcn_s_setprio(1);
    for (int j = 1; j + 1 < NT; j += 2) {
      SBAR(); QKT(pB0, pB1, j & 3); finish8a(pA0, pA1, pf); SCHED_R1(); SBAR();
      if (!(ABL & 8)) DMA8(j + 2, (j + 2) & 3); SBAR();
      PVT((j - 1) & 3); partial8(pB0); finish8b(pA0, pA1, l_reg); SCHED_R2();
      BARV("2");
      SBAR(); QKT(pA0, pA1, (j + 1) & 3); finish8a(pB0, pB1, pf); SCHED_R1(); SBAR();
      if (!(ABL & 8) && j + 3 < NT) DMA8(j + 3, (j + 3) & 3); SBAR();
      PVT(j & 3); partial8(pA0); finish8b(pB0, pB1, l_reg); SCHED_R2();
      if (j + 3 < NT) BARV("2"); else BARV("0");
    }
    __builtin_amdgcn_s_setprio(0);
#undef SCHED_R1
#undef SCHED_R2
#undef SG
    SBAR(); QKT(pB0, pB1, (NT - 1) & 3);
    FSM(pA0, pA1, alA); SBAR();
    PVT((NT - 2) & 3); PSM(pB0, pB1, mnB, alB);
    FSM(pB0, pB1, alB); SBAR();
    PVT((NT - 1) & 3);
#undef BARV
#undef DMA8
  } else {
  SLOAD(SE, 0); asm volatile("s_waitcnt vmcnt(0)" ::: "memory"); SWRITE(0, SE); __syncthreads();
  QKT(pA0, pA1, 0);
  PSM(pA0, pA1, mnA, alA);
  SLOAD(SO, KVBLK); if constexpr (SDEPTH == 2) { if (2 < NT) SLOAD(SE, 2 * KVBLK); }
  SWAIT(); SWRITE(1, SO); __syncthreads();
  int bk = 1, bv = 0, bw = 2;
#define ROT3() do { const int _t = bv; bv = bk; bk = bw; bw = _t; } while (0)
  for (int j = 1; j + 1 < NT; j += 2) {
    SBAR(); QKT(pB0, pB1, bk);
    FSM(pA0, pA1, alA); SBAR();
    if (!(ABL & 8)) SLOAD(SO, (j + SDEPTH) * KVBLK); SBAR();
    PVT(bv); PSM(pB0, pB1, mnB, alB);
    if (!(ABL & 8)) { SWAIT(); SWRITE(bw, SE); }
    RSC(alB); if (!(ABL & 4)) __syncthreads();
    ROT3();
    SBAR(); QKT(pA0, pA1, bk);
    FSM(pB0, pB1, alB); SBAR();
    if (!(ABL & 8) && (SDEPTH == 1 || j + 3 < NT)) SLOAD(SE, (j + 1 + SDEPTH) * KVBLK); SBAR();
    PVT(bv); PSM(pA0, pA1, mnA, alA);
    if (!(ABL & 8)) { SWAIT(); SWRITE(bw, SO); }
    RSC(alA); if (!(ABL & 4)) __syncthreads();
    ROT3();
  }
  SBAR(); QKT(pB0, pB1, bk);
  FSM(pA0, pA1, alA); SBAR();
  PVT(bv); PSM(pB0, pB1, mnB, alB);
  __syncthreads(); RSC(alB);
  FSM(pB0, pB1, alB); SBAR();
  PVT(bk);
#undef ROT3
  }
  if constexpr (NOMAX) { auto rr = __builtin_amdgcn_permlane32_swap(__float_as_uint(l_reg), __float_as_uint(l_reg), false, false); l_reg = __uint_as_float(rr[0]) + __uint_as_float(rr[1]); }
  if constexpr (K8) {
    int* bad_l = (int*)(lds + 3 * SHM_V + 3 * SHM_K + NW * 64 * 4);
    const int bad = (ABL == 0 && __any(!(l_reg < 5.0e4f))) ? 1 : 0; if (lane == 0) bad_l[wid] = bad; }
  if (hi == 0) li_l[r32] = l_reg; asm volatile("s_waitcnt lgkmcnt(0)" ::: "memory");
  float rli[16];
#pragma unroll
  for (int r = 0; r < 16; ++r) rli[r] = __builtin_amdgcn_rcpf(li_l[crow(r, hi)]);
  __syncthreads();
  if constexpr (K8) { const int* bad_l = (const int*)(lds + 3 * SHM_V + 3 * SHM_K + NW * 64 * 4); int anyb = 0;
#pragma unroll
    for (int w = 0; w < NW; ++w) anyb |= bad_l[w];
    if (__builtin_amdgcn_readfirstlane(anyb)) return false; }
  bf16* Os = (bf16*)(lds + wid * 8192);
#pragma unroll
  for (int r = 0; r < 16; ++r) { const int orow = crow(r, hi);
#pragma unroll
    for (int d0 = 0; d0 < 4; ++d0) Os[orow * 128 + d0 * 32 + r32] = (bf16)(cvtpk(o[d0][r] * rli[r], 0.f) & 0xffffu); }
  int tide = threadIdx.x; asm volatile("" : "+v"(tide));
  bf16* Ow = Ob + (long)((tide >> 6) * QBLK) * LDO;
#pragma unroll
  for (int k = 0; k < 8; ++k) { const int ci = k * 64 + (tide & 63), row = ci >> 4, c16 = ci & 15;
    const u32x4 v = *reinterpret_cast<const u32x4*>(Os + row * 128 + c16 * 8);
    *reinterpret_cast<u32x4*>(Ow + (long)row * LDO + c16 * 8) = v; }
#undef SLOAD
#undef SWRITE
#undef QKT
#undef PVT
#undef SWAIT
#undef RESC
#undef PSM
#undef FSM
#undef RSC
  return true;
}


#undef KSWZ
#undef KSWZ8
#undef V8SWZ
#undef SBAR
}

#define GAS __attribute__((address_space(1)))
#define LAS __attribute__((address_space(3)))
typedef unsigned v4u __attribute__((ext_vector_type(4)));
typedef float f32x4 __attribute__((ext_vector_type(4)));
typedef short bf16x8 __attribute__((ext_vector_type(8)));
typedef GAS unsigned gu32;
typedef GAS unsigned long long gu64;
#define RLX_AGENT __ATOMIC_RELAXED, __HIP_MEMORY_SCOPE_AGENT
#define LDS_WAIT() asm volatile("s_waitcnt lgkmcnt(0)" ::: "memory")
#define VM_WAIT() asm volatile("s_waitcnt vmcnt(0)" ::: "memory")
__device__ __forceinline__ unsigned long long rt() { return __builtin_amdgcn_s_memrealtime(); }
__device__ __forceinline__ unsigned f2bf(float f) { unsigned u = __builtin_bit_cast(unsigned, f); return (u + 0x7fffu + ((u >> 16) & 1u)) >> 16; }
__device__ __forceinline__ unsigned pk2(float lo, float hi) { return f2bf(lo) | (f2bf(hi) << 16); }

#define XB_TMO      128
#define XB_XCNT(j)  (256  + 64 * (j))
#define XB_XSUB(j)  (1280 + 64 * (j))
#define XB_XGEN(j)  (2304 + 64 * (j))
#define XB_TOP      3328
#define XB_TOPGEN   3392
#define XCD_BAR_WORDS 3456
#define XB_SPIN_CAP (1u << 18)

__device__ __forceinline__ unsigned xb_ld(unsigned* p)              { return __hip_atomic_load(p, __ATOMIC_RELAXED, __HIP_MEMORY_SCOPE_AGENT); }
__device__ __forceinline__ unsigned xb_add(unsigned* p, unsigned v) { return __hip_atomic_fetch_add(p, v, __ATOMIC_RELAXED, __HIP_MEMORY_SCOPE_AGENT); }
__device__ __forceinline__ unsigned xb_xcc_id() { return (unsigned)__builtin_amdgcn_s_getreg((3 << 11) | 20) & 0xFu; }
#define XB_SPIN(cond, bar) do { unsigned _sp = 0; while (cond) { __builtin_amdgcn_s_sleep(1); \
    if ((++_sp & 255u) == 0u) { if (xb_ld(&(bar)[XB_TMO])) break; if (_sp > XB_SPIN_CAP) { atomicAdd(&(bar)[XB_TMO], 1u); break; } } } } while (0)

struct XcdBarrier {
    unsigned* bar; unsigned x;
    volatile LAS unsigned* st;
};

__device__ __forceinline__ XcdBarrier xcd_barrier_post(unsigned* bar, volatile LAS unsigned* st) {
    XcdBarrier b; b.bar = bar; b.x = xb_xcc_id(); b.st = st;
    if (threadIdx.x == 0) (void)xb_add(&bar[XB_XCNT(b.x)], 1u);
    return b;
}
__device__ __forceinline__ void xcd_barrier_complete(unsigned* bar, unsigned x, unsigned& nloc, unsigned& nx) {
    const unsigned G = gridDim.x * gridDim.y * gridDim.z;
    unsigned sum, cnt, mine, sp = 0u;
    for (;;) {
        sum = 0u; cnt = 0u; mine = 0u;
#pragma unroll
        for (unsigned j = 0; j < 16; ++j) { const unsigned c = xb_ld(&bar[XB_XCNT(j)]); sum += c; cnt += (c > 0u) ? 1u : 0u; mine = (j == x) ? c : mine; }
        if (sum == G) break;
        __builtin_amdgcn_s_sleep(1);
        if ((++sp & 255u) == 0u) { if (xb_ld(&bar[XB_TMO])) break; if (sp > XB_SPIN_CAP) { atomicAdd(&bar[XB_TMO], 1u); break; } }
    }
    nloc = mine > 0u ? mine : 1u; nx = cnt > 0u ? cnt : 1u;
}

__device__ __forceinline__ void xcd_barrier(const XcdBarrier& b) {
    asm volatile("s_waitcnt vmcnt(0)" ::: "memory");
    __syncthreads();
    if (threadIdx.x == 0) {
        unsigned* bar = b.bar;
        __builtin_amdgcn_s_waitcnt(0);
        unsigned nloc = b.st[0], nx = b.st[1];
        if (nloc == 0u) { xcd_barrier_complete(bar, b.x, nloc, nx); b.st[0] = nloc; b.st[1] = nx; }
        const unsigned old = xb_add(&bar[XB_XSUB(b.x)], 1u);
        const unsigned gen = old / nloc;
        if (old + 1u == (gen + 1u) * nloc) {
            __builtin_amdgcn_fence(__ATOMIC_RELEASE, "agent");
            asm volatile("s_waitcnt vmcnt(0)" ::: "memory");
            const unsigned og = xb_add(&bar[XB_TOP], 1u);
            const unsigned tg = og / nx;
            if (og + 1u == (tg + 1u) * nx) xb_add(&bar[XB_TOPGEN], 1u);
            else XB_SPIN(xb_ld(&bar[XB_TOPGEN]) == tg, bar);
            __builtin_amdgcn_fence(__ATOMIC_ACQUIRE, "agent");
            xb_add(&bar[XB_XGEN(b.x)], 1u);
            asm volatile("s_waitcnt vmcnt(0)" ::: "memory");
        } else {
            XB_SPIN(xb_ld(&bar[XB_XGEN(b.x)]) == gen, bar);
            __builtin_amdgcn_fence(__ATOMIC_ACQUIRE, "agent");
            asm volatile("s_waitcnt vmcnt(0)" ::: "memory");
        }
    }
    __syncthreads();
}

typedef unsigned short bf16;
typedef float f32x2 __attribute__((ext_vector_type(2)));
typedef float f32x16 __attribute__((ext_vector_type(16)));
typedef __bf16 bf16x2_t __attribute__((ext_vector_type(2)));
constexpr int NWAVES = 8, NTHR = 512;
constexpr int LDS_BYTES = 147456, LDSCTL_OFF = LDS_BYTES - 256;
constexpr int CW_CMAXQ = 16384;
constexpr int CW_CMAX = 8192;
constexpr int CW_VF = 96;
constexpr int CW_BAR = 1024;
static_assert((CW_BAR + XCD_BAR_WORDS) * 4 <= (int)CTL_ZERO_BYTES, "control words inside the memset region");

struct Args {
    const float *x, *c, *ada_w, *ada_b, *norm_mix_w, *w_in, *q_norm_w, *k_norm_w, *w_attn_o, *pool_mix_w, *pool_scale, *w_pool_o, *w_out, *norm_ffn_w,
                *w_query, *sub_keys, *expert_u, *expert_v, *final_norm_w;
    float* out; unsigned char* ws; int ph_lo, ph_hi;
};

__device__ __forceinline__ unsigned pkbf(float lo, float hi) { return pg8::cvt_pk_bf16(lo, hi); }
__device__ __forceinline__ float bflo(unsigned w) { return __builtin_bit_cast(float, w << 16); }
__device__ __forceinline__ float bfhi(unsigned w) { return __builtin_bit_cast(float, w & 0xffff0000u); }
template <int M> __device__ __forceinline__ int shx_i(int x, bool upper) {
    if constexpr (M == 1) return __builtin_amdgcn_update_dpp(0, x, 0xB1, 0xF, 0xF, false);
    else if constexpr (M == 2) return __builtin_amdgcn_update_dpp(0, x, 0x4E, 0xF, 0xF, false);
    else if constexpr (M == 8) return __builtin_amdgcn_update_dpp(0, x, 0x128, 0xF, 0xF, false);
    else if constexpr (M == 4 || M == 16) return __builtin_amdgcn_ds_swizzle(x, (M << 10) | 0x1F);
    else { static_assert(M == 32, "shx: 1, 2, 4, 8, 16 or 32"); int y = x; asm volatile("" : "+v"(y));
        const auto rr = __builtin_amdgcn_permlane32_swap((unsigned)x, (unsigned)y, false, false); return (int)(upper ? rr[0] : rr[1]); }
}
__device__ __forceinline__ float shx_hm(float v) { return __builtin_bit_cast(float, __builtin_amdgcn_update_dpp(0, __builtin_bit_cast(int, v), 0x141, 0xF, 0xF, false)); }
__device__ __forceinline__ float shx16p(float v, bool odd16) { int x = __builtin_bit_cast(int, v), y = x; asm volatile("" : "+v"(y));
    const auto rr = __builtin_amdgcn_permlane16_swap((unsigned)x, (unsigned)y, false, false); return __builtin_bit_cast(float, (int)(odd16 ? rr[0] : rr[1])); }
template <int M> __device__ __forceinline__ float shx(float v, bool upper = false) { return __builtin_bit_cast(float, shx_i<M>(__builtin_bit_cast(int, v), upper)); }
__device__ __forceinline__ float wave_sum(float v) {
    v += shx<1>(v); v += shx<2>(v); v += shx<4>(v); v += shx<8>(v); v += shx<16>(v);
    return __builtin_bit_cast(float, __builtin_amdgcn_readlane(__builtin_bit_cast(int, v), 0)) + __builtin_bit_cast(float, __builtin_amdgcn_readlane(__builtin_bit_cast(int, v), 32));
}
__device__ __forceinline__ float wave_max(float v) {
    v = fmaxf(v, shx<1>(v)); v = fmaxf(v, shx<2>(v)); v = fmaxf(v, shx<4>(v)); v = fmaxf(v, shx<8>(v)); v = fmaxf(v, shx<16>(v));
    return fmaxf(__builtin_bit_cast(float, __builtin_amdgcn_readlane(__builtin_bit_cast(int, v), 0)), __builtin_bit_cast(float, __builtin_amdgcn_readlane(__builtin_bit_cast(int, v), 32)));
}
__device__ __forceinline__ unsigned q8x4(float a, float b, float c, float d, float inv) {
    const int ia = (int)rintf(fminf(fmaxf(a * inv, -127.f), 127.f)), ib = (int)rintf(fminf(fmaxf(b * inv, -127.f), 127.f)), ic = (int)rintf(fminf(fmaxf(c * inv, -127.f), 127.f)), id = (int)rintf(fminf(fmaxf(d * inv, -127.f), 127.f));
    return (unsigned)(ia & 255) | ((unsigned)(ib & 255) << 8) | ((unsigned)(ic & 255) << 16) | ((unsigned)(id & 255) << 24);
}
__device__ __forceinline__ float dot2bf(unsigned a, unsigned b, float acc) { return __builtin_amdgcn_fdot2_f32_bf16(__builtin_bit_cast(bf16x2_t, a), __builtin_bit_cast(bf16x2_t, b), acc, false); }

__device__ __forceinline__ void p0_wmax_item(const float* W, unsigned* CMAX, int item, int lane) {
    const int cg = item >> 4, kc = item & 15, n = cg * 64 + lane; const float* wp = W + (size_t)(kc * 64) * 4096 + n;
    float am = 0.f;
#pragma unroll 32
    for (int k = 0; k < 64; ++k) am = fmaxf(am, fabsf(wp[(size_t)k * 4096]));
    atomicMax(CMAX + n, __builtin_bit_cast(unsigned, am));
}
__device__ __forceinline__ void win8_item(const float* W, const unsigned* CMAX, unsigned char* WT8, float* SW, int item, int lane) {
    const int cg = item >> 4, kc = item & 15, n = cg * 64 + lane; const float* wp = W + (size_t)(kc * 64) * 4096 + n;
    const float am = __builtin_bit_cast(float, __hip_atomic_load(CMAX + n, __ATOMIC_RELAXED, __HIP_MEMORY_SCOPE_AGENT));
    const float sw = (am > 0.f) ? am * (1.f / 127.f) : 1.f, inv = 1.f / sw;
    if (kc == 0) SW[n] = sw;
#pragma unroll
    for (int k0 = 0; k0 < 64; k0 += 16) { float v[16];
#pragma unroll
        for (int j = 0; j < 16; ++j) v[j] = wp[(size_t)(k0 + j) * 4096];
        v4u o; o.x = q8x4(v[0], v[1], v[2], v[3], inv); o.y = q8x4(v[4], v[5], v[6], v[7], inv); o.z = q8x4(v[8], v[9], v[10], v[11], inv); o.w = q8x4(v[12], v[13], v[14], v[15], inv);
        *(v4u*)(WT8 + (size_t)n * 1024 + kc * 64 + k0) = o; }
}
__device__ __forceinline__ void p0_transpose_item(const float* W, int K, int N, bf16* WT, LAS float* scr, int item, int lane) {
    const int nblk = N / 32, kb = item / nblk, nb = item % nblk, k0 = 64 * kb, n0 = 32 * nb;
#pragma unroll 16
    for (int i = 0; i < 32; ++i) { const int kk = 2 * i + (lane >> 5); scr[kk * 33 + (lane & 31)] = W[(size_t)(k0 + kk) * N + n0 + (lane & 31)]; }
    LDS_WAIT(); asm volatile("" ::: "memory");
    const int c = lane & 7;
#pragma unroll
    for (int j = 0; j < 4; ++j) { const int n = (lane >> 3) + 8 * j; const LAS float* s = scr + (8 * c) * 33 + n;
        v4u o; o.x = pkbf(s[0 * 33], s[1 * 33]); o.y = pkbf(s[2 * 33], s[3 * 33]); o.z = pkbf(s[4 * 33], s[5 * 33]); o.w = pkbf(s[6 * 33], s[7 * 33]);
        *(v4u*)(WT + (size_t)(n0 + n) * K + k0 + 8 * c) = o; }
    LDS_WAIT(); asm volatile("" ::: "memory");
}
__device__ __forceinline__ void cvt8_range(const float* src, bf16* dst, size_t n8, int gt, int NGT) {
    for (size_t i0 = gt; i0 < n8; i0 += (size_t)NGT * 4) {
        f32x4 a[4], b[4];
#pragma unroll
        for (int u = 0; u < 4; ++u) { const size_t i = i0 + (size_t)u * NGT, ic = (i < n8) ? i : i0; a[u] = *(const f32x4*)(src + ic * 8); b[u] = *(const f32x4*)(src + ic * 8 + 4); }
#pragma unroll
        for (int u = 0; u < 4; ++u) { const size_t i = i0 + (size_t)u * NGT; if (i >= n8) break;
            v4u o; o.x = pkbf(a[u][0], a[u][1]); o.y = pkbf(a[u][2], a[u][3]); o.z = pkbf(b[u][0], b[u][1]); o.w = pkbf(b[u][2], b[u][3]);
            *(v4u*)(dst + i * 8) = o; }
    }
}
__device__ __forceinline__ void p0_prologue(const Args& a, LAS unsigned char* lds, int tid, int lane, int wave, int bid, int G, int part  ) {
    unsigned char* ws = a.ws;
    const int gw = bid * NWAVES + wave, NGW = G * NWAVES, gt = bid * NTHR + tid, NGT = G * NTHR;
    if (part == 0) {
        LAS float* cs = (LAS float*)lds;
        LAS float* red = (LAS float*)(lds + 16384);
        float* MOD = (float*)(ws + WS_MOD);
        if (bid < 192 || G < 192) {
            for (int k = tid; k < 1024; k += NTHR)
#pragma unroll
                for (int b = 0; b < 4; ++b) { const float v = a.c[b * 1024 + k]; cs[k * 4 + b] = v / (1.f + __expf(-v)); }
            __syncthreads();
            for (int bt = bid; bt < 192; bt += G) {
                const int l = bt / 96, n0 = (bt % 96) * 64;
                const float* wp = a.ada_w + ((size_t)l * 1024 + wave * 128) * 6144 + n0 + lane;
                float acc0 = 0.f, acc1 = 0.f, acc2 = 0.f, acc3 = 0.f;
#pragma unroll 32
                for (int kk = 0; kk < 128; ++kk) {
                    const float wv = wp[(size_t)kk * 6144];
                    const f32x4 c4 = *(const LAS f32x4*)(cs + (wave * 128 + kk) * 4);
                    acc0 += c4[0] * wv; acc1 += c4[1] * wv; acc2 += c4[2] * wv; acc3 += c4[3] * wv;
                }
                red[(wave * 4 + 0) * 64 + lane] = acc0; red[(wave * 4 + 1) * 64 + lane] = acc1; red[(wave * 4 + 2) * 64 + lane] = acc2; red[(wave * 4 + 3) * 64 + lane] = acc3;
                __syncthreads();
                if (tid < 256) { const int b = tid >> 6; float s = a.ada_b[l * 6144 + n0 + lane];
#pragma unroll
                    for (int w = 0; w < 8; ++w) s += red[(w * 4 + b) * 64 + lane];
                    MOD[(size_t)(l * 4 + b) * 6144 + n0 + lane] = s; }
                __syncthreads();
            }
        }
        __syncthreads();
    }
    if (part == 0) return;
    {
        f32x2* RT = (f32x2*)(ws + WS_ROPE);
        for (int idx = gt; idx < 192 * 32; idx += NGT) {
            const int pos = idx >> 5, i = idx & 31; const float pv = (float)(pos < 128 ? pos : pos - 128);
            const float inv = exp2f(-(float)i * (13.287712379549449f / 32.f));
            const float ang = pv * inv;
            f32x2 cs2; cs2.x = __cosf(ang); cs2.y = __sinf(ang); RT[idx] = cs2;
        }
    }
    {
        LAS float* scr = (LAS float*)(lds + wave * 16384);
        constexpr int I_IN = 1024, I_AO = 16 * 32, I_OUT = 16 * 32, I_L = I_AO + I_OUT;
        for (int it = gw; it < 2 * I_IN + 2 * I_L; it += NGW) {
            if (it < 2 * I_IN) { const int l = it / I_IN, r = it % I_IN; p0_wmax_item(a.w_in + (size_t)l * 1024 * 4096, (unsigned*)(ws + WS_CTL) + CW_CMAX + l * 4096, r, lane); continue; }
            const int l = (it - 2 * I_IN) / I_L; int r = (it - 2 * I_IN) % I_L;
            if (r < I_AO) { p0_transpose_item(a.w_attn_o + (size_t)l * 1024 * 1024, 1024, 1024, (bf16*)(ws + WS_WAO) + (size_t)l * 1024 * 1024, scr, r, lane); continue; } r -= I_AO;
            p0_transpose_item(a.w_out + (size_t)l * 1024 * 1024, 1024, 1024, (bf16*)(ws + WS_WOUT) + (size_t)l * 1024 * 1024, scr, r, lane);
        }
    }
    {
        bf16* W2 = (bf16*)(ws + WS_WPO);
        for (int it = gw; it < 2 * 4 * 16 * 16; it += NGW) {
            const int l = it >> 10, g = (it >> 8) & 3, cc = (it >> 4) & 15, nb = it & 15, n = nb * 64 + lane;
            const float* mp = a.pool_mix_w + ((size_t)(l * 4 + g) * 128 + cc * 8) * 128;
            const float* sp = a.pool_scale + l * 512 + g * 128;
            const float* wp = a.w_pool_o + ((size_t)l * 512 + g * 128) * 1024 + n;
            float acc[8] = {0.f, 0.f, 0.f, 0.f, 0.f, 0.f, 0.f, 0.f};
#pragma unroll 1
            for (int db = 0; db < 128; db += 32) {
                float wv[32];
#pragma unroll
                for (int d = 0; d < 32; ++d) wv[d] = wp[(size_t)(db + d) * 1024];
#pragma unroll
                for (int d = 0; d < 32; ++d) { const float w2 = wv[d] * sp[db + d];
#pragma unroll
                    for (int i = 0; i < 8; ++i) acc[i] += mp[i * 128 + db + d] * w2; } }
            v4u o; o.x = pkbf(acc[0], acc[1]); o.y = pkbf(acc[2], acc[3]); o.z = pkbf(acc[4], acc[5]); o.w = pkbf(acc[6], acc[7]);
            *(v4u*)(W2 + ((size_t)l * 1024 + n) * 512 + g * 128 + cc * 8) = o;
        }
    }
    cvt8_range(a.w_query, (bf16*)(ws + WS_WQB), (size_t)2 * 1024 * 4096 / 8, gt, NGT);
    {
        bf16* AB = (bf16*)(ws + WS_ABD);
        for (int i = gt; i < 2 * 2048 * 64; i += NGT) {
            const int l = i / (2048 * 64), r = i % (2048 * 64), n = r >> 6, kc = (n >> 8) * 64 + (r & 63), hp = n >> 7;
            v4u o = {0u, 0u, 0u, 0u};
            if ((kc >> 5) == hp) { const float* p = a.sub_keys + ((size_t)(l * 16 + hp) * 128 + (n & 127)) * 256 + (kc & 31) * 8;
                const f32x4 u0 = *(const f32x4*)p, u1 = *(const f32x4*)(p + 4); o.x = pkbf(u0[0], u0[1]); o.y = pkbf(u0[2], u0[3]); o.z = pkbf(u1[0], u1[1]); o.w = pkbf(u1[2], u1[3]); }
            *(v4u*)(AB + ((size_t)l * 2048 + n) * 4096 + kc * 8) = o;
        }
    }
}

template <bool XBF = false  >
__device__ __forceinline__ void normmod_phase(const float* X, const float* w, const float* modl, int sh_off, int sc_off, bf16* XN, int gw, int NGW, int lane, unsigned* XQ = nullptr, float* SX = nullptr) {
    const int per = (TOK + NGW - 1) / NGW, r0 = gw * per, r1 = (r0 + per < TOK) ? r0 + per : TOK;
    int curb = -1; f32x4 A[4], Bv[4];
    for (int rb = r0; rb < r1; rb += 4) {
        const int b = rb >> 13;
        if (b != curb) { curb = b;
#pragma unroll
            for (int j = 0; j < 4; ++j) { const f32x4 wv = *(const f32x4*)(w + 4 * lane + 256 * j); const f32x4 sc = *(const f32x4*)(modl + (size_t)b * 6144 + sc_off + 4 * lane + 256 * j);
                A[j] = wv * (sc + 1.0f); Bv[j] = *(const f32x4*)(modl + (size_t)b * 6144 + sh_off + 4 * lane + 256 * j); } }
        f32x4 v[4][4]; float ss[4];
#pragma unroll
        for (int q = 0; q < 4; ++q) { const int r = (rb + q < r1) ? rb + q : r1 - 1; ss[q] = 0.f;
#pragma unroll
            for (int j = 0; j < 4; ++j) {
                if (XBF) { const unsigned long long raw = *(const unsigned long long*)((const bf16*)X + (size_t)r * 2048 + 1024 + 4 * lane + 256 * j); const unsigned lo = (unsigned)raw, hi = (unsigned)(raw >> 32);
                    v[q][j] = f32x4{bflo(lo), bfhi(lo), bflo(hi), bfhi(hi)}; }
                else v[q][j] = *(const f32x4*)(X + (size_t)r * 1024 + 4 * lane + 256 * j); } }
#pragma unroll
        for (int q = 0; q < 4; ++q)
#pragma unroll
            for (int j = 0; j < 4; ++j) ss[q] += (v[q][j][0] * v[q][j][0] + v[q][j][1] * v[q][j][1]) + (v[q][j][2] * v[q][j][2] + v[q][j][3] * v[q][j][3]);
#pragma unroll
        for (int q = 0; q < 4; ++q) { const int r = rb + q; if (r >= r1) break;
            const float rstd = rsqrtf(wave_sum(ss[q]) * (1.f / 1024.f) + EPS);
#pragma unroll
            for (int j = 0; j < 4; ++j) { const f32x4 y = v[q][j] * rstd * A[j] + Bv[j]; v[q][j] = y;
                f32x2 o; ((unsigned*)&o)[0] = pkbf(y[0], y[1]); ((unsigned*)&o)[1] = pkbf(y[2], y[3]);
                if (XN) *(f32x2*)(XN + (size_t)r * 1024 + 4 * lane + 256 * j) = o; }
            if (XQ) { float am = 0.f;
#pragma unroll
                for (int j = 0; j < 4; ++j) am = fmaxf(fmaxf(am, fmaxf(fabsf(v[q][j][0]), fabsf(v[q][j][1]))), fmaxf(fabsf(v[q][j][2]), fabsf(v[q][j][3])));
                am = wave_max(am); const float sx = (am > 0.f) ? am * (1.f / 127.f) : 1.f, inv = 1.f / sx;
#pragma unroll
                for (int j = 0; j < 4; ++j) XQ[(size_t)r * 256 + lane + 64 * j] = q8x4(v[q][j][0], v[q][j][1], v[q][j][2], v[q][j][3], inv);
                if (lane == 0) SX[r] = sx; } }
    }
}

__device__ __forceinline__ void qknorm_rope_phase(bf16* Q, bf16* K, unsigned char* K8, const float* qw, const float* kw, const f32x2* RT, int gw, int NGW, int lane, size_t probe_off = 0  ) {
    const int sub = lane & 15, grp = lane >> 4;
    for (int i = gw; i < TOK * 2 / 4; i += NGW) {
        const int it = i * 4 + grp, t = it >> 1, hd = 8 + (it & 1);
        bf16* p = (hd < 8) ? (Q + (size_t)t * 1024 + hd * 128 + sub * 8) : (K + (size_t)t * 256 + (hd - 8) * 128 + sub * 8);
        const float* wn = ((hd < 8) ? qw : kw) + sub * 8;
        const v4u raw = *(const v4u*)p;
        float x[8] = {bflo(raw.x), bfhi(raw.x), bflo(raw.y), bfhi(raw.y), bflo(raw.z), bfhi(raw.z), bflo(raw.w), bfhi(raw.w)};
        float ss = 0.f;
#pragma unroll
        for (int e = 0; e < 8; ++e) ss += x[e] * x[e];
        ss += shx<1>(ss); ss += shx<2>(ss); ss += shx<4>(ss); ss += shx<8>(ss);
        const float rstd = rsqrtf(ss * (1.f / 128.f) + EPS);
        const f32x4 w0 = *(const f32x4*)wn, w1 = *(const f32x4*)(wn + 4);
        float y[8];
#pragma unroll
        for (int e = 0; e < 8; ++e) y[e] = x[e] * rstd * (e < 4 ? w0[e] : w1[e - 4]);
        const int tl = t & (SEQ - 1), pos = (sub & 8) ? (128 + (tl & 63)) : (tl >> 6);
        const f32x2* rt = RT + pos * 32 + (sub & 3) * 8;
        const float sgn = (sub & 4) ? 1.f : -1.f;
        float o[8];
        const float qc = (hd < 8) ? 0.088388347648318440f * 1.4426950408889634f : 1.f;
#pragma unroll
        for (int e = 0; e < 8; ++e) { const float pr = shx<4>(y[e]); const f32x2 cs2 = rt[e]; o[e] = (y[e] * cs2.x + sgn * pr * cs2.y) * qc; }
        v4u ov; ov.x = pkbf(o[0], o[1]); ov.y = pkbf(o[2], o[3]); ov.z = pkbf(o[4], o[5]); ov.w = pkbf(o[6], o[7]);
        *(v4u*)(p + probe_off) = ov;
        if (K8 != nullptr && probe_off == 0) { int w0 = __builtin_amdgcn_cvt_pk_fp8_f32(o[0], o[1], 0, false); w0 = __builtin_amdgcn_cvt_pk_fp8_f32(o[2], o[3], w0, true);
            int w1 = __builtin_amdgcn_cvt_pk_fp8_f32(o[4], o[5], 0, false); w1 = __builtin_amdgcn_cvt_pk_fp8_f32(o[6], o[7], w1, true);
            uint2 wv; wv.x = (unsigned)w0; wv.y = (unsigned)w1;
            *(uint2*)(K8 + (size_t)t * 256 + (hd - 8) * 128 + (sub >> 3) * 64 + (sub & 1) * 32 + ((sub >> 1) & 3) * 8) = wv; }
    }
}
__device__ __forceinline__ void v8t_phase(const bf16* V, unsigned char* V8T, unsigned* vflag, int gw, int NGW, int lane) {
    const int qd = lane & 15, grp = lane >> 4;
    const int bytepos = (qd & 1) * 32 + (qd >> 3) * 16 + 4 * ((qd & 7) >> 1);
    float mx = 0.f;
    for (int i = gw; i < (TOK / 64) * 2 * 16 / 4; i += NGW) {
        const int it = i * 4 + grp, dblk = it & 15, kvh = (it >> 4) & 1, tg = it >> 5;
        const bf16* src = V + ((size_t)tg * 64 + qd * 4) * 256 + kvh * 128 + dblk * 8;
        const v4u r0 = *(const v4u*)src, r1 = *(const v4u*)(src + 256), r2 = *(const v4u*)(src + 512), r3 = *(const v4u*)(src + 768);
        unsigned char* dst = V8T + ((size_t)tg * 2 + kvh) * 8192 + (size_t)(dblk * 8) * 64 + bytepos;
#define V8_ONE(dd, F, C) do { const float a = F(r0.C), b = F(r1.C), c = F(r2.C), d = F(r3.C); mx = fmaxf(mx, fmaxf(fmaxf(fabsf(a), fabsf(b)), fmaxf(fabsf(c), fabsf(d)))); \
            int w = __builtin_amdgcn_cvt_pk_fp8_f32(a, b, 0, false); w = __builtin_amdgcn_cvt_pk_fp8_f32(c, d, w, true); *(unsigned*)(dst + (dd) * 64) = (unsigned)w; } while (0)
        V8_ONE(0, bflo, x); V8_ONE(1, bfhi, x); V8_ONE(2, bflo, y); V8_ONE(3, bfhi, y); V8_ONE(4, bflo, z); V8_ONE(5, bfhi, z); V8_ONE(6, bflo, w); V8_ONE(7, bfhi, w);
#undef V8_ONE
    }
    const unsigned fl = (__any(mx > 440.f) ? 1u : 0u) | (__any(mx >= 0.25f) ? 2u : 0u);
    if (lane == 0 && fl) atomicOr(vflag, fl);
}
__device__ __forceinline__ void poolwin_phase(const bf16* UP, bf16* Mo, int gt, int NGT) {
    for (int i = gt; i < (TOK / 8) * 64; i += NGT) {
        const int tg = i >> 6, ch = i & 63, g = ch >> 4, half = 1 << g, ta = tg * 8, tla = ta & (SEQ - 1);
        const bf16* base = UP + (size_t)(ta - tla) * 512 + ch * 8;
        v4u cen[8], ent[7], lev[7];
#pragma unroll
        for (int k = 0; k < 8; ++k) cen[k] = *(const v4u*)(base + (size_t)(tla + k) * 512);
#pragma unroll
        for (int k = 0; k < 7; ++k) { const int re = tla + k + half, rl = tla + k - half;
            ent[k] = *(const v4u*)(base + (size_t)(re < SEQ ? re : SEQ - 1) * 512); lev[k] = *(const v4u*)(base + (size_t)(rl >= 0 ? rl : 0) * 512); }
        float s[8] = {0.f, 0.f, 0.f, 0.f, 0.f, 0.f, 0.f, 0.f};
#define PW_ACC(v, sg) do { s[0] += (sg) * bflo((v).x); s[1] += (sg) * bfhi((v).x); s[2] += (sg) * bflo((v).y); s[3] += (sg) * bfhi((v).y); \
            s[4] += (sg) * bflo((v).z); s[5] += (sg) * bfhi((v).z); s[6] += (sg) * bflo((v).w); s[7] += (sg) * bfhi((v).w); } while (0)
        {
#pragma unroll
          for (int k = 0; k < 7; ++k) if (k < half) { PW_ACC(cen[k], 1.f); if (tla > 0) PW_ACC(lev[k], 1.f); }
          if (half == 8) { PW_ACC(cen[7], 1.f); if (tla > 0) { const v4u lev7 = *(const v4u*)(base + (size_t)(tla - 1) * 512); PW_ACC(lev7, 1.f); } } }
#pragma unroll
        for (int k = 0; k < 8; ++k) {
            const int tl = tla + k, lo = (tl - half > 0) ? tl - half : 0, hi = (tl + half < SEQ) ? tl + half : SEQ;
            const v4u c = cen[k];
            const float ic = 1.f / (float)(hi - lo);
            v4u o; o.x = pkbf(s[0] * ic - bflo(c.x), s[1] * ic - bfhi(c.x)); o.y = pkbf(s[2] * ic - bflo(c.y), s[3] * ic - bfhi(c.y));
            o.z = pkbf(s[4] * ic - bflo(c.z), s[5] * ic - bfhi(c.z)); o.w = pkbf(s[6] * ic - bflo(c.w), s[7] * ic - bfhi(c.w));
            *(v4u*)(Mo + (size_t)(ta + k) * 512 + ch * 8) = o;
            if (k < 7) { const float fe = (tl + half < SEQ) ? 1.f : 0.f, fl = (tl - half >= 0) ? -1.f : 0.f; PW_ACC(ent[k < 7 ? k : 0], fe); PW_ACC(lev[k < 7 ? k : 0], fl); }
        }
#undef PW_ACC
    }
}

__device__ __forceinline__ unsigned f2ord(float f) { const unsigned u = __builtin_bit_cast(unsigned, f); return (u & 0x80000000u) ? ~u : (u | 0x80000000u); }
__device__ __forceinline__ float ord2f(unsigned o) { const unsigned u = (o & 0x80000000u) ? (o & 0x7fffffffu) : ~o; return __builtin_bit_cast(float, u); }
#define TK_INSERT(L, xin) do { unsigned _x = (xin); _Pragma("unroll") for (int _i = 0; _i < 16; ++_i) { const unsigned _t = L[_i] > _x ? L[_i] : _x; _x = L[_i] > _x ? _x : L[_i]; L[_i] = _t; } } while (0)
#define TK_MERGE32(L) do { unsigned _P[16]; _Pragma("unroll") for (int _i = 0; _i < 16; ++_i) _P[_i] = (unsigned)shx_i<32>((int)L[_i], hi != 0); \
    _Pragma("unroll") for (int _i = 0; _i < 16; ++_i) L[_i] = L[_i] > _P[15 - _i] ? L[_i] : _P[15 - _i]; tk_bitonic_merge16(L); } while (0)

#define TK_CE(S, a, b) do { const unsigned _h = S[a] > S[b] ? S[a] : S[b], _l = S[a] > S[b] ? S[b] : S[a]; S[a] = _h; S[b] = _l; } while (0)
__device__ __forceinline__ void tk_sort16(unsigned (&S)[16]) {
    TK_CE(S, 0, 13); TK_CE(S, 1, 12); TK_CE(S, 2, 15); TK_CE(S, 3, 14); TK_CE(S, 4, 8); TK_CE(S, 5, 6); TK_CE(S, 7, 11); TK_CE(S, 9, 10);
    TK_CE(S, 0, 5); TK_CE(S, 1, 7); TK_CE(S, 2, 9); TK_CE(S, 3, 4); TK_CE(S, 6, 13); TK_CE(S, 8, 14); TK_CE(S, 10, 15); TK_CE(S, 11, 12);
    TK_CE(S, 0, 1); TK_CE(S, 2, 3); TK_CE(S, 4, 5); TK_CE(S, 6, 8); TK_CE(S, 7, 9); TK_CE(S, 10, 11); TK_CE(S, 12, 13); TK_CE(S, 14, 15);
    TK_CE(S, 0, 2); TK_CE(S, 1, 3); TK_CE(S, 4, 10); TK_CE(S, 5, 11); TK_CE(S, 6, 7); TK_CE(S, 8, 9); TK_CE(S, 12, 14); TK_CE(S, 13, 15);
    TK_CE(S, 1, 2); TK_CE(S, 3, 12); TK_CE(S, 4, 6); TK_CE(S, 5, 7); TK_CE(S, 8, 10); TK_CE(S, 9, 11); TK_CE(S, 13, 14);
    TK_CE(S, 1, 4); TK_CE(S, 2, 6); TK_CE(S, 5, 8); TK_CE(S, 7, 10); TK_CE(S, 9, 13); TK_CE(S, 11, 14);
    TK_CE(S, 2, 4); TK_CE(S, 3, 6); TK_CE(S, 9, 12); TK_CE(S, 11, 13);
    TK_CE(S, 3, 5); TK_CE(S, 6, 8); TK_CE(S, 7, 9); TK_CE(S, 10, 12);
    TK_CE(S, 3, 4); TK_CE(S, 5, 6); TK_CE(S, 7, 8); TK_CE(S, 9, 10); TK_CE(S, 11, 12);
    TK_CE(S, 6, 7); TK_CE(S, 8, 9);
}
__device__ __forceinline__ void tk_bitonic_merge16(unsigned (&S)[16]) {
    TK_CE(S, 0, 8); TK_CE(S, 1, 9); TK_CE(S, 2, 10); TK_CE(S, 3, 11); TK_CE(S, 4, 12); TK_CE(S, 5, 13); TK_CE(S, 6, 14); TK_CE(S, 7, 15);
    TK_CE(S, 0, 4); TK_CE(S, 1, 5); TK_CE(S, 2, 6); TK_CE(S, 3, 7); TK_CE(S, 8, 12); TK_CE(S, 9, 13); TK_CE(S, 10, 14); TK_CE(S, 11, 15);
    TK_CE(S, 0, 2); TK_CE(S, 1, 3); TK_CE(S, 4, 6); TK_CE(S, 5, 7); TK_CE(S, 8, 10); TK_CE(S, 9, 11); TK_CE(S, 12, 14); TK_CE(S, 13, 15);
    TK_CE(S, 0, 1); TK_CE(S, 2, 3); TK_CE(S, 4, 5); TK_CE(S, 6, 7); TK_CE(S, 8, 9); TK_CE(S, 10, 11); TK_CE(S, 12, 13); TK_CE(S, 14, 15);
}

__device__ __forceinline__ void wc8_phase(const bf16* WC, unsigned char* WC8, float* SWC, int gw, int NGW, int lane) {
    for (int row = gw; row < 2 * 2048; row += NGW) {
        const v4u r0 = *(const v4u*)(WC + (size_t)row * 1024 + lane * 16), r1 = *(const v4u*)(WC + (size_t)row * 1024 + lane * 16 + 8);
        float v[16] = {bflo(r0.x), bfhi(r0.x), bflo(r0.y), bfhi(r0.y), bflo(r0.z), bfhi(r0.z), bflo(r0.w), bfhi(r0.w), bflo(r1.x), bfhi(r1.x), bflo(r1.y), bfhi(r1.y), bflo(r1.z), bfhi(r1.z), bflo(r1.w), bfhi(r1.w)};
        float am = 0.f;
#pragma unroll
        for (int j = 0; j < 16; ++j) am = fmaxf(am, fabsf(v[j]));
        am = wave_max(am); const float sw = (am > 0.f) ? am * (1.f / 127.f) : 1.f, inv = 1.f / sw;
        v4u o; o.x = q8x4(v[0], v[1], v[2], v[3], inv); o.y = q8x4(v[4], v[5], v[6], v[7], inv); o.z = q8x4(v[8], v[9], v[10], v[11], inv); o.w = q8x4(v[12], v[13], v[14], v[15], inv);
        *(v4u*)(WC8 + (size_t)row * 1024 + lane * 16) = o; if (lane == 0) SWC[row] = sw;
    }
}
template <class Sched> __device__ __forceinline__ void topk_phase(const bf16* SP  , int* EIDX, float* GS, const Sched& S, int lane, int wave) {
    const int r32 = lane & 31, hi = lane >> 5;
#define TK_LOADQ(sq, tl, hh, p) do { const bf16* _s = SP + ((((((size_t)(tl) * 8 + (hh)) * 2 + (p)) * 4) * 2 + hi) * 32 + r32) * 16; _Pragma("unroll") for (int _kt = 0; _kt < 4; ++_kt) { sq[2 * _kt] = *(const v4u*)(_s + _kt * 1024); sq[2 * _kt + 1] = *(const v4u*)(_s + _kt * 1024 + 8); } } while (0)
#define TK_SELECT(sq, p, LOUT) do { unsigned L[16]; \
        _Pragma("unroll") for (int kt = 0; kt < 4; ++kt) { const v4u _a = sq[2 * kt], _b = sq[2 * kt + 1]; \
            const float sc[16] = {bflo(_a.x), bfhi(_a.x), bflo(_a.y), bfhi(_a.y), bflo(_a.z), bfhi(_a.z), bflo(_a.w), bfhi(_a.w), bflo(_b.x), bfhi(_b.x), bflo(_b.y), bfhi(_b.y), bflo(_b.z), bfhi(_b.z), bflo(_b.w), bfhi(_b.w)}; \
            unsigned S_[16]; _Pragma("unroll") for (int r = 0; r < 16; ++r) { const int n = kt * 32 + (r & 3) + 8 * (r >> 2) + 4 * hi; S_[r] = (f2ord(sc[r]) & 0xFFFFFF80u) | (unsigned)(127 - n); } \
            tk_sort16(S_); \
            if (kt == 0) { _Pragma("unroll") for (int i = 0; i < 16; ++i) L[i] = S_[i]; } \
            else { _Pragma("unroll") for (int i = 0; i < 16; ++i) L[i] = L[i] > S_[15 - i] ? L[i] : S_[15 - i]; tk_bitonic_merge16(L); } } \
        TK_MERGE32(L); _Pragma("unroll") for (int i = 0; i < 16; ++i) LOUT[i] = L[i]; } while (0)
    v4u bqA[8], bqB[8];
    pg8::Unit u, un;
    if (S.next(0, u)) TK_LOADQ(bqA, u.pm * 8 + wave, u.pn, 0);
    for (int ui = 0; S.next(ui, u); ++ui) {
        const int h = u.pn, tile = u.pm * 8 + wave, tok = tile * 32 + r32;
        unsigned LA[16], LB[16];
        TK_LOADQ(bqB, tile, h, 1);
        TK_SELECT(bqA, 0, LA);
        TK_SELECT(bqB, 1, LB);
        { const bool hn = S.next(ui + 1, un); TK_LOADQ(bqA, hn ? un.pm * 8 + wave : tile, hn ? un.pn : h, 0); }
        float va[16], vb[16];
#pragma unroll
        for (int i = 0; i < 16; ++i) { va[i] = ord2f(LA[i] & 0xFFFFFF80u); vb[i] = ord2f(LB[i] & 0xFFFFFF80u); }
        unsigned ta[4] = {0u, 0u, 0u, 0u}, tb[4] = {0u, 0u, 0u, 0u};
#pragma unroll
        for (int i = 0; i < 16; ++i) { ta[i >> 2] |= (127u - (LA[i] & 127u)) << ((i & 3) * 8); tb[i >> 2] |= (127u - (LB[i] & 127u)) << ((i & 3) * 8); }
        unsigned C[16];
#pragma unroll
        for (int j = 0; j < 16; ++j) { const unsigned key = (f2ord(va[0] + vb[j]) & 0xFFFFFF00u) | (unsigned)(255 - j); C[j] = hi ? 0u : key; }
        { const float _s = hi ? (va[1] + vb[1]) : (va[1] + vb[0]); const unsigned _id = hi ? 238u : 239u; const unsigned key = (f2ord(_s) & 0xFFFFFF00u) | _id; TK_INSERT(C, key); }
        { const float _s = hi ? (va[1] + vb[3]) : (va[1] + vb[2]); const unsigned _id = hi ? 236u : 237u; const unsigned key = (f2ord(_s) & 0xFFFFFF00u) | _id; TK_INSERT(C, key); }
        { const float _s = hi ? (va[1] + vb[5]) : (va[1] + vb[4]); const unsigned _id = hi ? 234u : 235u; const unsigned key = (f2ord(_s) & 0xFFFFFF00u) | _id; TK_INSERT(C, key); }
        { const float _s = hi ? (va[1] + vb[7]) : (va[1] + vb[6]); const unsigned _id = hi ? 232u : 233u; const unsigned key = (f2ord(_s) & 0xFFFFFF00u) | _id; TK_INSERT(C, key); }
        { const float _s = hi ? (va[2] + vb[1]) : (va[2] + vb[0]); const unsigned _id = hi ? 222u : 223u; const unsigned key = (f2ord(_s) & 0xFFFFFF00u) | _id; TK_INSERT(C, key); }
        { const float _s = hi ? (va[2] + vb[3]) : (va[2] + vb[2]); const unsigned _id = hi ? 220u : 221u; const unsigned key = (f2ord(_s) & 0xFFFFFF00u) | _id; TK_INSERT(C, key); }
        { const float _s = hi ? (va[3] + vb[0]) : (va[2] + vb[4]); const unsigned _id = hi ? 207u : 219u; const unsigned key = (f2ord(_s) & 0xFFFFFF00u) | _id; TK_INSERT(C, key); }
        { const float _s = hi ? (va[3] + vb[2]) : (va[3] + vb[1]); const unsigned _id = hi ? 205u : 206u; const unsigned key = (f2ord(_s) & 0xFFFFFF00u) | _id; TK_INSERT(C, key); }
        { const float _s = hi ? (va[4] + vb[0]) : (va[3] + vb[3]); const unsigned _id = hi ? 191u : 204u; const unsigned key = (f2ord(_s) & 0xFFFFFF00u) | _id; TK_INSERT(C, key); }
        { const float _s = hi ? (va[4] + vb[2]) : (va[4] + vb[1]); const unsigned _id = hi ? 189u : 190u; const unsigned key = (f2ord(_s) & 0xFFFFFF00u) | _id; TK_INSERT(C, key); }
        { const float _s = hi ? (va[5] + vb[1]) : (va[5] + vb[0]); const unsigned _id = hi ? 174u : 175u; const unsigned key = (f2ord(_s) & 0xFFFFFF00u) | _id; TK_INSERT(C, key); }
        { const float _s = hi ? (va[6] + vb[1]) : (va[6] + vb[0]); const unsigned _id = hi ? 158u : 159u; const unsigned key = (f2ord(_s) & 0xFFFFFF00u) | _id; TK_INSERT(C, key); }
        { const float _s = hi ? (va[7] + vb[1]) : (va[7] + vb[0]); const unsigned _id = hi ? 142u : 143u; const unsigned key = (f2ord(_s) & 0xFFFFFF00u) | _id; TK_INSERT(C, key); }
        { const float _s = hi ? (va[9] + vb[0]) : (va[8] + vb[0]); const unsigned _id = hi ? 111u : 127u; const unsigned key = (f2ord(_s) & 0xFFFFFF00u) | _id; TK_INSERT(C, key); }
        { const float _s = hi ? (va[11] + vb[0]) : (va[10] + vb[0]); const unsigned _id = hi ? 79u : 95u; const unsigned key = (f2ord(_s) & 0xFFFFFF00u) | _id; TK_INSERT(C, key); }
        { const float _s = hi ? (va[13] + vb[0]) : (va[12] + vb[0]); const unsigned _id = hi ? 47u : 63u; const unsigned key = (f2ord(_s) & 0xFFFFFF00u) | _id; TK_INSERT(C, key); }
        { const float _s = hi ? (va[15] + vb[0]) : (va[14] + vb[0]); const unsigned _id = hi ? 15u : 31u; const unsigned key = (f2ord(_s) & 0xFFFFFF00u) | _id; TK_INSERT(C, key); }
        TK_MERGE32(C);
        const float smax = ord2f(C[0] & 0xFFFFFF00u);
        float ev[16]; float esum = 0.f; int ei[16];
#pragma unroll
        for (int k = 0; k < 16; ++k) {
            const unsigned cid = 255u - (C[k] & 255u), ci = cid >> 4, cj = cid & 15u;
            const unsigned wa = (ci & 8u) ? ((ci & 4u) ? ta[3] : ta[2]) : ((ci & 4u) ? ta[1] : ta[0]);
            const unsigned wb = (cj & 8u) ? ((cj & 4u) ? tb[3] : tb[2]) : ((cj & 4u) ? tb[1] : tb[0]);
            const unsigned ia = (wa >> ((ci & 3u) * 8u)) & 255u, ib = (wb >> ((cj & 3u) * 8u)) & 255u;
            ei[k] = (int)(ia * 128u + ib);
            ev[k] = __expf(ord2f(C[k] & 0xFFFFFF00u) - smax); esum += ev[k];
        }
        const float inv = 1.f / esum;
        if (hi == 0) { int* ep = EIDX + (size_t)tok * 128 + h * 16;
#pragma unroll
            for (int q = 0; q < 4; ++q) { v4u o; o.x = (unsigned)ei[4 * q]; o.y = (unsigned)ei[4 * q + 1]; o.z = (unsigned)ei[4 * q + 2]; o.w = (unsigned)ei[4 * q + 3]; *(v4u*)(ep + 4 * q) = o; }
        } else { float* gp = GS + (size_t)tok * 128 + h * 16;
#pragma unroll
            for (int q = 0; q < 4; ++q) { f32x4 o; o[0] = ev[4 * q] * inv; o[1] = ev[4 * q + 1] * inv; o[2] = ev[4 * q + 2] * inv; o[3] = ev[4 * q + 3] * inv; *(f32x4*)(gp + 4 * q) = o; }
        }
    }
}

#undef TK_LOADQ
#undef TK_SELECT
constexpr float V_SCALE = 16.f;
__device__ __forceinline__ f32x2 fp8lo(unsigned w) { return __builtin_amdgcn_cvt_pk_f32_fp8((int)w, false); }
__device__ __forceinline__ f32x2 fp8hi(unsigned w) { return __builtin_amdgcn_cvt_pk_f32_fp8((int)w, true); }
__device__ __forceinline__ void cvt16_fp8_range(const float* src, unsigned char* dst, size_t n16, float scale, int gt, int NGT) {
    for (size_t i = gt; i < n16; i += NGT) {
        const f32x4 a = *(const f32x4*)(src + i * 16) * scale, b = *(const f32x4*)(src + i * 16 + 4) * scale, c = *(const f32x4*)(src + i * 16 + 8) * scale, d = *(const f32x4*)(src + i * 16 + 12) * scale;
        v4u o; int w;
        w = __builtin_amdgcn_cvt_pk_fp8_f32(a[0], a[1], 0, false); w = __builtin_amdgcn_cvt_pk_fp8_f32(a[2], a[3], w, true); o.x = (unsigned)w;
        w = __builtin_amdgcn_cvt_pk_fp8_f32(b[0], b[1], 0, false); w = __builtin_amdgcn_cvt_pk_fp8_f32(b[2], b[3], w, true); o.y = (unsigned)w;
        w = __builtin_amdgcn_cvt_pk_fp8_f32(c[0], c[1], 0, false); w = __builtin_amdgcn_cvt_pk_fp8_f32(c[2], c[3], w, true); o.z = (unsigned)w;
        w = __builtin_amdgcn_cvt_pk_fp8_f32(d[0], d[1], 0, false); w = __builtin_amdgcn_cvt_pk_fp8_f32(d[2], d[3], w, true); o.w = (unsigned)w;
        *(v4u*)(dst + i * 16) = o;
    }
}
__device__ __forceinline__ void cvt16_fp8_chunked(const float* src, unsigned char* dst, float scale, int gt, int NGT) {
    constexpr size_t NI = (size_t)DEPTH * NEXP * 64;
    for (size_t i0 = gt; i0 < NI; i0 += (size_t)NGT * 4) {
        f32x4 va[4], vb[4], vc[4], vd[4];
#pragma unroll
        for (int u = 0; u < 4; ++u) { const size_t i = i0 + (size_t)u * NGT; const float* sp = src + (i < NI ? i : i0) * 16;
            va[u] = *(const f32x4*)(sp) * scale; vb[u] = *(const f32x4*)(sp + 4) * scale; vc[u] = *(const f32x4*)(sp + 8) * scale; vd[u] = *(const f32x4*)(sp + 12) * scale; }
#pragma unroll
        for (int u = 0; u < 4; ++u) { const size_t i = i0 + (size_t)u * NGT; if (i >= NI) break;
            const size_t l = i >> 20, rem = i & ((1u << 20) - 1u), e = rem >> 6, r = rem & 63, c = r >> 3, j = (r & 7) * 16;
            const f32x4 a = va[u], b = vb[u], cc = vc[u], d = vd[u];
            v4u o; int w;
            w = __builtin_amdgcn_cvt_pk_fp8_f32(a[0], a[1], 0, false); w = __builtin_amdgcn_cvt_pk_fp8_f32(a[2], a[3], w, true); o.x = (unsigned)w;
            w = __builtin_amdgcn_cvt_pk_fp8_f32(b[0], b[1], 0, false); w = __builtin_amdgcn_cvt_pk_fp8_f32(b[2], b[3], w, true); o.y = (unsigned)w;
            w = __builtin_amdgcn_cvt_pk_fp8_f32(cc[0], cc[1], 0, false); w = __builtin_amdgcn_cvt_pk_fp8_f32(cc[2], cc[3], w, true); o.z = (unsigned)w;
            w = __builtin_amdgcn_cvt_pk_fp8_f32(d[0], d[1], 0, false); w = __builtin_amdgcn_cvt_pk_fp8_f32(d[2], d[3], w, true); o.w = (unsigned)w;
            *(v4u*)(dst + (l << 24) + ((c * NEXP + e) * 128 + j)) = o; }
    }
}
__device__ __forceinline__ void cvt_u_int8_chunked(const float* src, unsigned char* dst, float* SU, int gw, int NGW, int lane) {
    for (int rb = gw * 4; rb < DEPTH * NEXP; rb += NGW * 4) {
        f32x4 va[4], vb[4], vc[4], vd[4];
#pragma unroll
        for (int u = 0; u < 4; ++u) { const float* sp = src + (size_t)(rb + u) * 1024 + lane * 16; va[u] = *(const f32x4*)(sp); vb[u] = *(const f32x4*)(sp + 4); vc[u] = *(const f32x4*)(sp + 8); vd[u] = *(const f32x4*)(sp + 12); }
#pragma unroll
        for (int u = 0; u < 4; ++u) { const int row = rb + u, l = row >> 14, e = row & (NEXP - 1);
            const f32x4 a = va[u], b = vb[u], c = vc[u], d = vd[u];
            float am = fmaxf(fmaxf(fmaxf(fabsf(a[0]), fabsf(a[1])), fmaxf(fabsf(a[2]), fabsf(a[3]))), fmaxf(fmaxf(fabsf(b[0]), fabsf(b[1])), fmaxf(fabsf(b[2]), fabsf(b[3]))));
            am = fmaxf(am, fmaxf(fmaxf(fmaxf(fabsf(c[0]), fabsf(c[1])), fmaxf(fabsf(c[2]), fabsf(c[3]))), fmaxf(fmaxf(fabsf(d[0]), fabsf(d[1])), fmaxf(fabsf(d[2]), fabsf(d[3])))));
            am = wave_max(am); const float su = (am > 0.f) ? am * (1.f / 127.f) : 1.f, inv = 1.f / su;
            v4u o; o.x = q8x4(a[0], a[1], a[2], a[3], inv); o.y = q8x4(b[0], b[1], b[2], b[3], inv); o.z = q8x4(c[0], c[1], c[2], c[3], inv); o.w = q8x4(d[0], d[1], d[2], d[3], inv);
            *(v4u*)(dst + ((size_t)l << 24) + (((size_t)(lane >> 3) * NEXP + e) * 128 + (lane & 7) * 16)) = o;
            if (lane == 0) SU[row] = su; }
    }
}
template <bool LAST, int GABL = 0, bool DRY = false>
__device__ __forceinline__ void gather_phase(const bf16* XF, const int* EIDX, const float* GS, const unsigned char* EU, const unsigned char* EV, bf16* XS  , float* XOUT  , const float* g2p  ,
                                             const float* wnext, const float* modn  , unsigned char* XQN  , float* SXN  , LAS unsigned char* lds, int gw, int NGW, int wave, int lane, int nrep  ,
                                             const unsigned char* XQ  , const float* SX  , const float* SU  ) {
    const int g = lane >> 3, s = lane & 7, b5 = lane & 32, b4 = lane & 16, b3 = lane & 8, s4 = lane & 4, s2 = lane & 2, s1 = lane & 1;
    LAS float* H = (LAS float*)(lds + wave * 8192);
    LAS float* SSL = (LAS float*)(lds + 65536 + wave * 4096);
#define LOAD_EV(dst, t) do { const v4u* _p = (const v4u*)(EIDX + (size_t)(t) * 128 + g * 16); dst[0] = _p[0]; dst[1] = _p[1]; dst[2] = _p[2]; dst[3] = _p[3]; } while (0)
#define EVI(ev, i) ((ev)[(i) >> 2][(i) & 3])
#define ROW(T, c, e) (*(const v4u*)(((T) + (size_t)(c) * NEXP * 128) + (((unsigned)(e) << 7) + (unsigned)(s * 16))))
    for (int grp = gw; grp < TOK / 16; grp += NGW) {
        const int t0 = grp * 16, b = t0 >> 13;
        for (int rep = 0; rep < nrep; ++rep) {
        constexpr bool ab1 = (GABL & 1) != 0, ab2 = (GABL & 2) != 0;
        {
            v4u ev0[4], ev1[4], ev2[4], r[16], xr;
            LOAD_EV(ev0, t0); LOAD_EV(ev1, t0 + 1);
            xr = *(const v4u*)(XQ + (size_t)t0 * 1024 + s * 16);
#pragma unroll
            for (int i = 0; i < 16; ++i) r[i] = ROW(EU, 0, EVI(ev0, i));
#pragma unroll 1
            for (int it = 0; it < 128; ++it) {
                const int c = it >> 4, tt = it & 15, itn = (it < 127) ? it + 1 : 127, cn = itn >> 4, ttn = itn & 15;
                const v4u xq = xr;
                xr = *(const v4u*)(XQ + (size_t)(t0 + ttn) * 1024 + cn * 128 + s * 16);
                LOAD_EV(ev2, t0 + ((it + 2) & 15));
                int pp[16];
#pragma unroll
                for (int i = 0; i < 16; ++i) {
                    if (ab1) { asm volatile("" :: "v"(r[i])); pp[i] = 0; } else {
                    int sm = __builtin_amdgcn_sdot4((int)r[i].x, (int)xq.x, 0, false); sm = __builtin_amdgcn_sdot4((int)r[i].y, (int)xq.y, sm, false);
                    sm = __builtin_amdgcn_sdot4((int)r[i].z, (int)xq.z, sm, false); pp[i] = __builtin_amdgcn_sdot4((int)r[i].w, (int)xq.w, sm, false); }
                    if (!ab2) r[i] = ROW(EU, cn, EVI(ev1, i));
                    if ((i & 3) == 3) __builtin_amdgcn_sched_barrier(0);
                }
                int q8[8], q4[4], q2[2];
#pragma unroll
                for (int j = 0; j < 8; ++j) { const int keep = s4 ? pp[j + 8] : pp[j], send = s4 ? pp[j] : pp[j + 8]; q8[j] = keep + __builtin_amdgcn_update_dpp(0, send, 0x141, 0xF, 0xF, false); }
#pragma unroll
                for (int j = 0; j < 4; ++j) { const int keep = s2 ? q8[j + 4] : q8[j], send = s2 ? q8[j] : q8[j + 4]; q4[j] = keep + shx_i<2>(send, false); }
#pragma unroll
                for (int j = 0; j < 2; ++j) { const int keep = s1 ? q4[j + 2] : q4[j], send = s1 ? q4[j] : q4[j + 2]; q2[j] = keep + shx_i<1>(send, false); }
                typedef int i32x2 __attribute__((ext_vector_type(2)));
                LAS i32x2* hp = (LAS i32x2*)(H + tt * 128 + 2 * lane);
                i32x2 hv = i32x2{q2[0], q2[1]};
                if (c != 0) hv += *hp;
                *hp = hv;
#pragma unroll
                for (int q = 0; q < 4; ++q) { ev0[q] = ev1[q]; ev1[q] = ev2[q]; }
            }
        }
        {   typedef int i32x2 __attribute__((ext_vector_type(2)));
#pragma unroll 1
            for (int tb = 0; tb < 16; tb += 4) {
                i32x2 hi2[4], e2[4]; f32x2 g2[4]; float sx[4], su0[4], su1[4];
#pragma unroll
                for (int u = 0; u < 4; ++u) { const int tt = tb + u; hi2[u] = *(const LAS i32x2*)(H + tt * 128 + 2 * lane); e2[u] = *(const i32x2*)(EIDX + (size_t)(t0 + tt) * 128 + 2 * lane);
                    sx[u] = SX[t0 + tt]; g2[u] = *(const f32x2*)(GS + (size_t)(t0 + tt) * 128 + 2 * lane); }
#pragma unroll
                for (int u = 0; u < 4; ++u) { su0[u] = SU[e2[u].x]; su1[u] = SU[e2[u].y]; }
#pragma unroll
                for (int u = 0; u < 4; ++u) { const int tt = tb + u;
                    f32x2 h2; h2.x = (float)hi2[u].x * (sx[u] * su0[u]); h2.y = (float)hi2[u].y * (sx[u] * su1[u]);
                    f32x2 a2; a2.x = 0.5f * h2.x * (1.f + erff(h2.x * 0.70710678118654752f)) * g2[u].x; a2.y = 0.5f * h2.y * (1.f + erff(h2.y * 0.70710678118654752f)) * g2[u].y;
                    *(LAS f32x2*)(H + tt * 128 + 2 * lane) = a2; }
            }
        }
        {
            v4u ev0[4], ev1[4], ev2[4], r[16];
            LOAD_EV(ev0, t0); LOAD_EV(ev1, t0 + 1);
#pragma unroll
            for (int i = 0; i < 16; ++i) r[i] = ROW(EV, 0, EVI(ev0, i));
#pragma unroll 1
            for (int it = 0; it < 128; ++it) {
                const int c = it >> 4, tt = it & 15, itn = (it < 127) ? it + 1 : 127, cn = itn >> 4;
                const int colp = c * 128 + s * 16 + 2 * g; const unsigned xraw = *(const unsigned*)(XS + (size_t)(t0 + tt) * 2048 + 1024 + colp); const f32x2 xi = f32x2{bflo(xraw), bfhi(xraw)}, gg = *(const f32x2*)(g2p + (size_t)b * 6144 + colp);
                f32x4 av[4];
#pragma unroll
                for (int q = 0; q < 4; ++q) av[q] = *(const LAS f32x4*)(H + tt * 128 + g * 16 + 4 * q);
                LOAD_EV(ev2, t0 + ((it + 2) & 15));
                f32x2 o[8];
#pragma unroll
                for (int i = 0; i < 8; ++i) o[i] = f32x2{0.f, 0.f};
#pragma unroll
                for (int i = 0; i < 16; ++i) {
                    const float a = av[i >> 2][i & 3]; const f32x2 a2 = f32x2{a, a};
                    if (ab1) { asm volatile("" :: "v"(r[i]), "v"(a2)); } else {
                    o[0] += a2 * fp8lo(r[i].x); o[1] += a2 * fp8hi(r[i].x); o[2] += a2 * fp8lo(r[i].y); o[3] += a2 * fp8hi(r[i].y);
                    o[4] += a2 * fp8lo(r[i].z); o[5] += a2 * fp8hi(r[i].z); o[6] += a2 * fp8lo(r[i].w); o[7] += a2 * fp8hi(r[i].w); }
                    if (!ab2) r[i] = ROW(EV, cn, EVI(ev1, i));
                    if ((i & 3) == 3) __builtin_amdgcn_sched_barrier(0);
                }
                float q8[8], q4[4], q2[2];
#pragma unroll
                for (int j = 0; j < 8; ++j) { const float lo = (j & 1) ? o[j >> 1].y : o[j >> 1].x, hi_ = (j & 1) ? o[(j + 8) >> 1].y : o[(j + 8) >> 1].x;
                    const float keep = b5 ? hi_ : lo, send = b5 ? lo : hi_; q8[j] = keep + shx<32>(send, b5 != 0); }
#pragma unroll
                for (int j = 0; j < 4; ++j) { const float keep = b4 ? q8[j + 4] : q8[j], send = b4 ? q8[j] : q8[j + 4]; q4[j] = keep + shx16p(send, b4 != 0); }
#pragma unroll
                for (int j = 0; j < 2; ++j) { const float keep = b3 ? q4[j + 2] : q4[j], send = b3 ? q4[j] : q4[j + 2]; q2[j] = keep + shx<8>(send); }
                const int col = c * 128 + s * 16 + 2 * g, t = t0 + tt;
                bf16* xp = XS + (size_t)t * 2048 + 1024 + col;
                f32x2 x2; x2.x = xi.x + gg.x * (q2[0] * (1.f / V_SCALE)); x2.y = xi.y + gg.y * (q2[1] * (1.f / V_SCALE));
                if (!DRY && rep + 1 == nrep) *(unsigned*)xp = pkbf(x2.x, x2.y);
                float sq = x2.x * x2.x + x2.y * x2.y;
                if (c != 0) sq += SSL[tt * 64 + lane];
                SSL[tt * 64 + lane] = sq;
#pragma unroll
                for (int q = 0; q < 4; ++q) { ev0[q] = ev1[q]; ev1[q] = ev2[q]; }
            }
        }
        }
        if (DRY) continue;
        asm volatile("s_waitcnt vmcnt(0)" ::: "memory");
        {
            f32x4 PA[4], PB[4];
#pragma unroll
            for (int q = 0; q < 4; ++q) { const f32x4 wv = *(const f32x4*)(wnext + lane * 16 + 4 * q);
                if (LAST) { PA[q] = wv; PB[q] = f32x4{0.f, 0.f, 0.f, 0.f}; }
                else { PA[q] = wv * (*(const f32x4*)(modn + (size_t)b * 6144 + 1024 + lane * 16 + 4 * q) + 1.f); PB[q] = *(const f32x4*)(modn + (size_t)b * 6144 + lane * 16 + 4 * q); } }
#pragma unroll 1
            for (int tb = 0; tb < 16; tb += 4) {
                f32x4 xv4[4][4]; float rs[4];
#pragma unroll
                for (int u = 0; u < 4; ++u) { const bf16* xr = XS + (size_t)(t0 + tb + u) * 2048 + 1024 + lane * 16; rs[u] = SSL[(tb + u) * 64 + lane];
                    const v4u r0 = __builtin_nontemporal_load((const v4u*)xr), r1 = __builtin_nontemporal_load((const v4u*)(xr + 8));
                    xv4[u][0] = f32x4{bflo(r0.x), bfhi(r0.x), bflo(r0.y), bfhi(r0.y)}; xv4[u][1] = f32x4{bflo(r0.z), bfhi(r0.z), bflo(r0.w), bfhi(r0.w)};
                    xv4[u][2] = f32x4{bflo(r1.x), bfhi(r1.x), bflo(r1.y), bfhi(r1.y)}; xv4[u][3] = f32x4{bflo(r1.z), bfhi(r1.z), bflo(r1.w), bfhi(r1.w)}; }
#pragma unroll
                for (int u = 0; u < 4; ++u) { const int t = t0 + tb + u; float* xr = XOUT + (size_t)t * 1024 + lane * 16;
                    const float rstd = rsqrtf(wave_sum(rs[u]) * (1.f / 1024.f) + EPS);
                    f32x4 yq[4]; float am = 0.f;
#pragma unroll
                    for (int q = 0; q < 4; ++q) { const f32x4 y = xv4[u][q] * rstd * PA[q] + PB[q]; yq[q] = y;
                        if (LAST) { *(f32x4*)(xr + 4 * q) = y; }
                        else am = fmaxf(fmaxf(am, fmaxf(fabsf(y[0]), fabsf(y[1]))), fmaxf(fabsf(y[2]), fabsf(y[3]))); }
                    if (!LAST) { am = wave_max(am); const float sx = (am > 0.f) ? am * (1.f / 127.f) : 1.f, inv = 1.f / sx;
                        v4u xo; xo.x = q8x4(yq[0][0], yq[0][1], yq[0][2], yq[0][3], inv); xo.y = q8x4(yq[1][0], yq[1][1], yq[1][2], yq[1][3], inv);
                        xo.z = q8x4(yq[2][0], yq[2][1], yq[2][2], yq[2][3], inv); xo.w = q8x4(yq[3][0], yq[3][1], yq[3][2], yq[3][3], inv);
                        *(v4u*)(XQN + (size_t)t * 1024 + lane * 16) = xo; if (lane == 0) SXN[t] = sx; } }
            }
        }
    }
#undef LOAD_EV
#undef EVI
#undef ROW
}


#ifndef ATTN_CHECK
#define ATTN_CHECK 0
#endif
#if ATTN_CHECK
constexpr int CW_FLAG = 64;
__device__ __forceinline__ void attn_check(const bf16* Q, const bf16* K, const bf16* V, const bf16* Ot, unsigned* flag, LAS unsigned char* lds, int tid, int bid, const float* qw, const f32x2* rt) {
    LAS float* sc = (LAS float*)lds;
    LAS float* red = (LAS float*)(lds + 32768);
    for (int j = 0; j < 4; ++j) {
        const int sid = bid * 4 + j, b = sid & 3, h = (sid >> 2) & 7, t = (int)(((unsigned)sid * 2654435761u) >> 7) & 8191, kvh = h >> 2;
        const bf16* q = Q + ((size_t)(b * SEQ + t)) * 1024 + h * 128;
        LAS float* qn = (LAS float*)(lds + 36864);
        { float v = (tid < 128) ? bflo((unsigned)q[tid]) : 0.f; red[tid] = v * v; __syncthreads();
          if (tid == 0) { float m = 0.f; for (int i2 = 0; i2 < 128; ++i2) m += red[i2]; red[0] = rsqrtf(m / 128.f + 1e-6f); } __syncthreads();
          const float rs = red[0]; __syncthreads();
          if (tid < 128) red[tid] = v * rs * qw[tid]; __syncthreads();
          if (tid < 128) { const int sec = tid >> 6, din = tid & 63, i2 = din & 31, pos = sec ? 128 + (t & 63) : (t >> 6); const f32x2 c2 = rt[pos * 32 + i2];
              const float me = red[tid], pr = red[tid ^ 32]; qn[tid] = ((din < 32) ? (me * c2.x - pr * c2.y) : (me * c2.x + pr * c2.y)) * (0.088388347648318440f * 1.4426950408889634f); }
          __syncthreads(); }
        float mx = -1e30f;
        for (int s = tid; s < SEQ; s += NTHR) { const bf16* kr = K + ((size_t)(b * SEQ + s)) * 256 + kvh * 128; float d = 0.f;
            for (int e = 0; e < 128; ++e) d += qn[e] * bflo((unsigned)kr[e]);
            d *= 0.6931471805599453f; sc[s] = d;     mx = fmaxf(mx, d); }
        red[tid] = mx; __syncthreads();
        if (tid == 0) { float m = red[0]; for (int i = 1; i < NTHR; ++i) m = fmaxf(m, red[i]); red[0] = m; } __syncthreads();
        mx = red[0]; __syncthreads();
        float sm = 0.f; for (int s = tid; s < SEQ; s += NTHR) { const float p = expf(sc[s] - mx); sc[s] = p; sm += p; }
        red[tid] = sm; __syncthreads();
        if (tid == 0) { float m = 0.f; for (int i = 0; i < NTHR; ++i) m += red[i]; red[0] = m; } __syncthreads();
        const float inv = 1.f / red[0]; __syncthreads();
        float o = 0.f, ot = 0.f;
        if (tid < 128) { for (int s = 0; s < SEQ; ++s) o += sc[s] * bflo((unsigned)V[((size_t)(b * SEQ + s)) * 256 + (ATTN_CHECK == 2 ? (kvh ^ 1) : kvh) * 128 + tid]); o *= inv;
            ot = bflo((unsigned)Ot[((size_t)(b * SEQ + t)) * 1024 + h * 128 + tid]); }
        red[tid] = (tid < 128) ? o * o : 0.f; red[tid] = red[tid]; __syncthreads();
        if (tid == 0) { float m = 0.f; for (int i = 0; i < 128; ++i) m += red[i]; red[0] = sqrtf(m / 128.f); } __syncthreads();
        const float rms = red[0]; __syncthreads();
        red[tid] = (tid < 128) ? (o - ot) * (o - ot) : 0.f; __syncthreads();
        if (tid == 0) { float m = 0.f; for (int i = 0; i < 128; ++i) m += red[i]; if (!(sqrtf(m / 128.f) <= 0.2f * rms + 1e-6f)) atomicOr(flag, 1u); } __syncthreads();
        if (tid < 128 && !(fabsf(o - ot) <= 0.6f * rms + 1e-6f)) atomicOr(flag, 1u);
        __syncthreads();
    }
}
#endif
constexpr int N_PHASES = 1 + 11 * DEPTH;
#ifndef PH_MASK
#define PH_MASK 0xFFFF
#endif
#define PHON(k) (((PH_MASK) >> (k)) & 1)
#ifndef REP_MASK
#define REP_MASK 0
#endif
#define REPK(k) (((REP_MASK) >> (k)) & 1)
__global__ void __launch_bounds__(NTHR, 2) mega(Args a) {
    extern __shared__ __attribute__((aligned(16))) unsigned char lds_raw[];
    LAS unsigned char* lds = (LAS unsigned char*)lds_raw;
    const int bid = blockIdx.x, G = gridDim.x;
#define tid0 ((int)threadIdx.x)
    const int NGW = G * NWAVES, NGT = G * NTHR;
    unsigned char* ws = a.ws;
    volatile LAS unsigned* MISC = (volatile LAS unsigned*)(lds + LDSCTL_OFF);
    for (int u = tid0; u < (LDS_BYTES - LDSCTL_OFF) / 4; u += NTHR) MISC[u] = 0u;
    __syncthreads();
    const int lo = a.ph_lo, hi = a.ph_hi;
    XcdBarrier bar; bar.bar = (unsigned*)(ws + WS_CTL) + CW_BAR; bar.x = 0; bar.st = nullptr;
    if (hi - lo > 1) bar = xcd_barrier_post((unsigned*)(ws + WS_CTL) + CW_BAR, MISC + 8);
#define IN(k) (lo <= (k) && (k) < hi)
#ifndef BAR_REP
#define BAR_REP 1
#endif
#define SEAM(k) do { if (IN(k) && IN((k) + 1)) for (int _b = 0; _b < BAR_REP; ++_b) xcd_barrier(bar); } while (0)

#define MOD ((float*)(ws + WS_MOD))
#define XN ((bf16*)(ws + WS_XN))
#define Qb ((bf16*)(ws + WS_Q))
#define Kb ((bf16*)(ws + WS_K))
#define Vb ((bf16*)(ws + WS_V))
#define UPb ((bf16*)(ws + WS_UP))
#define GAb ((bf16*)(ws + WS_GA))
#define GPb ((bf16*)(ws + WS_GP))
#define Mb ((bf16*)(ws + WS_XN))
#define QPb ((bf16*)(ws + WS_PROJ))
#define EIDX ((int*)(ws + WS_EIDX))
#define GSb ((float*)(ws + WS_GS))
#define EUb ((const unsigned char*)(ws + WS_EXPU))
#define EVb ((const unsigned char*)(ws + WS_EXPV))

    if (PHON(0) && IN(0)) for (int rep = 0; rep <= REPK(0); ++rep) { const int w0 = __builtin_amdgcn_readfirstlane(tid0 >> 6);
        p0_prologue(a, lds, tid0, tid0 & 63, w0, bid, G, 0);
        if (w0 & 1) { cvt_u_int8_chunked(a.expert_u, ws + WS_EXPU, (float*)(ws + WS_SU), bid * NWAVES + w0, NGW, tid0 & 63); cvt16_fp8_chunked(a.expert_v, ws + WS_EXPV, V_SCALE, bid * NTHR + tid0, NGT); p0_prologue(a, lds, tid0, tid0 & 63, w0, bid, G, 1); }
        else { p0_prologue(a, lds, tid0, tid0 & 63, w0, bid, G, 1); cvt_u_int8_chunked(a.expert_u, ws + WS_EXPU, (float*)(ws + WS_SU), bid * NWAVES + w0, NGW, tid0 & 63); cvt16_fp8_chunked(a.expert_v, ws + WS_EXPV, V_SCALE, bid * NTHR + tid0, NGT); }
        __syncthreads(); }
    SEAM(0);

    for (int l = 0; l < DEPTH; ++l) {
        const int pb = 1 + 11 * l;
        unsigned char* ws;
        { unsigned long long wsi = (unsigned long long)a.ws; asm volatile("" : "+s"(wsi)); ws = (unsigned char*)(GAS unsigned char*)wsi; }
        int tid = tid0; asm volatile("" : "+v"(tid));
        int lane = tid & 63, wave = __builtin_amdgcn_readfirstlane(tid >> 6), gw = bid * NWAVES + wave, gt = bid * NTHR + tid;
#define modl (MOD + (size_t)l * 4 * 6144)
        bool att_nomax = true;
        if (PHON(1) && IN(pb + 0) && l == 0) for (int rep = 0; rep <= REPK(1); ++rep) normmod_phase(a.x, a.norm_mix_w, modl, 0, 1024, nullptr  , gw, NGW, lane, (unsigned*)(ws + WS_XQ2), (float*)(ws + WS_SX2));
        if (PHON(1) && IN(pb + 0) && l == 0) { for (int it = gw; it < 2 * 1024; it += NGW) { const int ll = (it >> 10) & 1;
                win8_item(a.w_in + (size_t)ll * 1024 * 4096, (const unsigned*)(ws + WS_CTL) + CW_CMAX + ll * 4096, ws + WS_WIN + (size_t)ll * 4096 * 1024, (float*)(ws + WS_SWIN) + ll * 4096, it & 1023, lane); }
            __syncthreads();
            for (int ll = 0; ll < 2; ++ll) {
                pg8::Gemm g{(const bf16*)(ws + WS_ABD) + (size_t)ll * 2048 * 4096, (const bf16*)(ws + WS_WQB) + (size_t)ll * 1024 * 4096, 2048, 1024, 4096, 8, 512 * 2};     pg8::StaticOrder S; S.init(2048, 1024, G, (bid + ll * (G / 2)) % G);
                pg8::EpiB<0> E{(bf16*)(ws + WS_WC) + (size_t)ll * 2048 * 1024, 1024, nullptr, nullptr, nullptr, nullptr, nullptr, nullptr, nullptr, nullptr};
                pg8::gemm_phase<pg8::EpiB<0>, pg8::StaticOrder, true, true>(lds, g, S, E); __syncthreads(); } }
        SEAM(pb + 0);
        if (PHON(2) && IN(pb + 1)) {
            pg8::Gemm g{(const bf16*)(ws + WS_XQ2), (const bf16*)(ws + WS_WIN + (size_t)l * 4096 * 1024), TOK, INC, DM / 2}; pg8::StaticOrder S; S.init(TOK, INC, G, bid);
            pg8::EpiB<1> E{nullptr, 0, nullptr, nullptr, (bf16*)(ws + WS_Q8)  , Kb, Vb, UPb, (bf16*)(ws + WS_XQ)  , (bf16*)(ws + WS_GA)  , (const float*)(ws + WS_SX2), (const float*)(ws + WS_SWIN) + l * 4096};
            for (int rep = 0; rep <= REPK(2); ++rep) { pg8::gemm_phase<pg8::EpiB<1>, pg8::StaticOrder, true, false, true>(lds, g, S, E); __syncthreads(); }
        }
        SEAM(pb + 1);
        if (PHON(3) && IN(pb + 2)) {
            if (REPK(12)) qknorm_rope_phase(Qb, Kb, nullptr, a.q_norm_w + l * 128, a.k_norm_w + l * 128, (const f32x2*)(ws + WS_ROPE), gw, NGW, lane, (size_t)(WS_EIDX - WS_Q) / 2);
            qknorm_rope_phase(Qb, Kb, ws + WS_K8, a.q_norm_w + l * 128, a.k_norm_w + l * 128, (const f32x2*)(ws + WS_ROPE), gw, NGW, lane);
            for (int rep = 0; rep <= REPK(3); ++rep) poolwin_phase(UPb, Mb, gt, NGT);
            v8t_phase(Vb, ws + WS_V8T, (unsigned*)(ws + WS_CTL) + CW_VF + l, gw, NGW, lane);
            if (l == 0) wc8_phase((const bf16*)(ws + WS_WC), ws + WS_WC8, (float*)(ws + WS_SWC), gw, NGW, lane);
        }
        SEAM(pb + 2);
#ifndef GATHER_PROBE_ABL
#define GATHER_PROBE_ABL 0
#endif
#ifndef ATT_PROBE_ABL
#define ATT_PROBE_ABL 0
#endif
#define ATT_UNITS(NM, TO_SCRATCH, SEL, REDO) ATT_UNITS_(NM, TO_SCRATCH, 0, SEL, REDO)
#define ATT_UNITS_(NM, TO_SCRATCH, ABLV, SEL, REDO) do { for (int i = 0;; ++i) { int x, g, qb; \
            if (G == 256) { if (i >= 4) break; x = bid & 7; g = i; qb = bid >> 3; } else { const int u = bid + i * G; if (u >= 1024) break; x = u >> 7; g = (u & 127) >> 5; qb = u & 31; } \
            if (!(((SEL) >> (i & 31)) & 1u)) continue; \
            const int b = x >> 1, kvh = x & 1, h = kvh * 4 + g; bf16* q0 = Qb + ((size_t)(b * SEQ + qb * 256)) * 1024 + h * 128; \
            const bf16* k0 = (NM) ? (const bf16*)(ws + WS_K8 + ((size_t)b * SEQ) * 256 + kvh * 128) : Kb + ((size_t)b * SEQ) * 256 + kvh * 128; \
            const bf16* v0 = (NM) ? (const bf16*)(ws + WS_V8T + ((size_t)(b * (SEQ / 64)) * 2 + kvh) * 8192) : Vb + ((size_t)b * SEQ) * 256 + kvh * 128; \
            const bool ok_ = att::attn_dense_body3<unsigned char, NM, NM, ABLV>((const unsigned char*)(ws + WS_Q8) + (q0 - Qb), k0, v0, (TO_SCRATCH) ? (bf16*)(ws + WS_EIDX) + (q0 - Qb) : q0, SEQ, (char*)lds_raw, a.q_norm_w + l * 128, (const float*)(ws + WS_ROPE), qb * 256); \
            if (!ok_) (REDO) |= 1u << (i & 31); __syncthreads(); } } while (0)
#define ATT_ALL(TO_SCRATCH, ABLV) do { unsigned sel_ = 0xFFFFFFFFu, none_ = 0u; if (att_nomax) { unsigned redo_ = 0u; ATT_UNITS_(true, TO_SCRATCH, ABLV, 0xFFFFFFFFu, redo_); sel_ = redo_; } \
            if (sel_) ATT_UNITS_(false, TO_SCRATCH, 0, sel_, none_); } while (0)
        if (ATTN_CHECK || (PHON(4) && IN(pb + 3))) { float mq = 0.f, mk = 0.f;
            for (int i = 0; i < 128; ++i) { mq = fmaxf(mq, fabsf(a.q_norm_w[l * 128 + i])); mk = fmaxf(mk, fabsf(a.k_norm_w[l * 128 + i])); }
            att_nomax = (16.65f * mq * mk) < 100.f && mq < 128.f && mk < 32.f && (1024 + G - 1) / G <= 32;
            att_nomax = att_nomax && __hip_atomic_load((unsigned*)(ws + WS_CTL) + CW_VF + l, __ATOMIC_RELAXED, __HIP_MEMORY_SCOPE_AGENT) == 2u; }
#if ATTN_CHECK
        if (l == 0) {
            ATT_ALL(true, 0);
            xcd_barrier(bar);
            attn_check(Qb, Kb, Vb, (const bf16*)(ws + WS_EIDX), (unsigned*)(ws + WS_CTL) + CW_FLAG, lds, tid, bid, a.q_norm_w, (const f32x2*)(ws + WS_ROPE));
            xcd_barrier(bar);
        }
#endif
        if (PHON(4) && IN(pb + 3)) {
            if (REPK(4)) ATT_ALL(true, ATT_PROBE_ABL);
            ATT_ALL(false, 0);
        }
        SEAM(pb + 3);
        tid = threadIdx.x; asm volatile("" : "+v"(tid)); lane = tid & 63; wave = __builtin_amdgcn_readfirstlane(tid >> 6); gw = bid * NWAVES + wave; gt = bid * NTHR + tid;
#if REP_MASK & 0xE0
        if (IN(pb + 4)) {
            bf16* SCR = (bf16*)(ws + WS_EIDX);
            if (REPK(5)) { pg8::Gemm g{Qb, (const bf16*)(ws + WS_WAO) + (size_t)l * 1024 * 1024, TOK, DM, DM}; pg8::StaticOrder S; S.init(TOK, DM, G, bid);
              pg8::EpiB<0> E{SCR, 1024, nullptr, nullptr, nullptr, nullptr, nullptr, nullptr, nullptr, nullptr}; pg8::gemm_phase<pg8::EpiB<0>, pg8::StaticOrder, true, true>(lds, g, S, E); __syncthreads(); }
            if (REPK(5)) { pg8::Gemm g{Mb, (const bf16*)(ws + WS_WMIX) + (size_t)l * 512 * 512, TOK, POOLW, POOLW}; pg8::StaticOrder S; S.init(TOK, POOLW, G, bid);
              pg8::EpiB<0> E{SCR, 512, nullptr, nullptr, nullptr, nullptr, nullptr, nullptr, nullptr, nullptr}; pg8::gemm_phase<pg8::EpiB<0>, pg8::StaticOrder, true, true>(lds, g, S, E); __syncthreads(); }
            if (REPK(6)) { pg8::Gemm g{UPb, (const bf16*)(ws + WS_WPO) + (size_t)l * 1024 * 512, TOK, DM, POOLW}; pg8::StaticOrder S; S.init(TOK, DM, G, bid);
              pg8::EpiB<0> E{SCR, 1024, nullptr, nullptr, nullptr, nullptr, nullptr, nullptr, nullptr, nullptr}; pg8::gemm_phase<pg8::EpiB<0>, pg8::StaticOrder, true, true>(lds, g, S, E); __syncthreads(); }
            if (REPK(7)) { pg8::Gemm g{GPb, (const bf16*)(ws + WS_WOUT) + (size_t)l * 1024 * 1024, TOK, DM, DM}; pg8::StaticOrder S; S.init(TOK, DM, G, bid);
              pg8::EpiB<0> E{SCR, 1024, nullptr, nullptr, nullptr, nullptr, nullptr, nullptr, nullptr, nullptr}; pg8::gemm_phase<pg8::EpiB<0>, pg8::StaticOrder, true, true>(lds, g, S, E); __syncthreads(); }
        }
#endif
        if (PHON(5) && IN(pb + 4)) {
            { pg8::Gemm g{Qb, (const bf16*)(ws + WS_WAO) + (size_t)l * 1024 * 1024, TOK, DM, DM}; pg8::StaticOrder S; S.init(TOK, DM, G, bid);
              pg8::EpiB<2> E{nullptr, 1024, nullptr, nullptr, (bf16*)(ws + WS_K)  , nullptr, nullptr, nullptr, (bf16*)(ws + WS_XQ)  , nullptr};
              pg8::gemm_phase<pg8::EpiB<2>, pg8::StaticOrder, true, true>(lds, g, S, E); }
            __syncthreads();
            { pg8::Gemm g{Mb, (const bf16*)(ws + WS_WPO) + (size_t)l * 1024 * 512, TOK, DM, POOLW}; pg8::StaticOrder S; S.init(TOK, DM, G, bid);
              pg8::EpiB<4> E{GPb, 1024, nullptr, nullptr, (bf16*)(ws + WS_K)  , nullptr, nullptr, nullptr, (bf16*)(ws + WS_GA)  , nullptr};
              pg8::gemm_phase<pg8::EpiB<4>, pg8::StaticOrder, true, true>(lds, g, S, E); }
        }
        SEAM(pb + 4);
        if (PHON(7) && IN(pb + 6)) {
            pg8::Gemm g{GPb, (const bf16*)(ws + WS_WOUT) + (size_t)l * 1024 * 1024, TOK, DM, DM}; pg8::StaticOrder S; S.init(TOK, DM, G, bid);
            pg8::EpiResid E{a.x, (bf16*)a.out, modl + 2048, (l == 0) ? 0 : 1};
            pg8::gemm_phase<pg8::EpiResid, pg8::StaticOrder, true, true>(lds, g, S, E);
        }
        SEAM(pb + 6);
        if (PHON(8) && IN(pb + 7)) for (int rep = 0; rep <= REPK(8); ++rep) normmod_phase<true>(a.out, a.norm_ffn_w + l * 1024, modl, 3072, 4096, nullptr  , gw, NGW, lane, (unsigned*)(ws + WS_XQ), (float*)(ws + WS_SX));
        SEAM(pb + 7);
        if (PHON(9) && IN(pb + 8)) {
            pg8::Gemm g{(const bf16*)(ws + WS_XQ), (const bf16*)(ws + WS_WC8 + (size_t)l * 2048 * 1024), TOK, 2048, DM / 2}; pg8::StaticOrder S; S.init(TOK, 2048, G, bid);
            pg8::EpiB<6> E{QPb, 2048, nullptr, nullptr, nullptr, nullptr, nullptr, nullptr, nullptr, nullptr, (const float*)(ws + WS_SX), (const float*)(ws + WS_SWC) + l * 2048};
            for (int rep = 0; rep <= REPK(9); ++rep) { pg8::gemm_phase<pg8::EpiB<6>, pg8::StaticOrder, true, false, true>(lds, g, S, E); __syncthreads(); }
            asm volatile("s_waitcnt vmcnt(0)" ::: "memory"); __syncthreads();
            for (int rep = 0; rep <= REPK(10); ++rep) topk_phase(QPb, EIDX, GSb, S, lane, wave);
        }
        SEAM(pb + 8);
        if (PHON(11) && IN(pb + 10)) {
            if (REPK(11)) gather_phase<true, GATHER_PROBE_ABL, true>(XN, EIDX, GSb, EUb + (size_t)l * NEXP * 1024, EVb + (size_t)l * NEXP * 1024, (bf16*)a.out, a.out, modl + 5120, a.final_norm_w, nullptr, ws + WS_XQ2, (float*)(ws + WS_SX2), lds, gw, NGW, wave, lane, 1, ws + WS_XQ, (const float*)(ws + WS_SX), (const float*)(ws + WS_SU) + (size_t)l * NEXP);
            if (l == 0) gather_phase<false>(XN, EIDX, GSb, EUb + (size_t)l * NEXP * 1024, EVb + (size_t)l * NEXP * 1024, (bf16*)a.out, a.out, modl + 5120, a.norm_mix_w + 1024, MOD + (size_t)4 * 6144, ws + WS_XQ2, (float*)(ws + WS_SX2), lds, gw, NGW, wave, lane, 1, ws + WS_XQ, (const float*)(ws + WS_SX), (const float*)(ws + WS_SU) + (size_t)l * NEXP);
            else gather_phase<true>(XN, EIDX, GSb, EUb + (size_t)l * NEXP * 1024, EVb + (size_t)l * NEXP * 1024, (bf16*)a.out, a.out, modl + 5120, a.final_norm_w, nullptr, ws + WS_XQ2, (float*)(ws + WS_SX2), lds, gw, NGW, wave, lane, 1, ws + WS_XQ, (const float*)(ws + WS_SX), (const float*)(ws + WS_SU) + (size_t)l * NEXP);
        }
        SEAM(pb + 10);
    }
#if ATTN_CHECK
    xcd_barrier(bar);
    if (__hip_atomic_load((unsigned*)(ws + WS_CTL) + CW_FLAG, __ATOMIC_RELAXED, __HIP_MEMORY_SCOPE_AGENT) != 0u)
        for (size_t i = (size_t)bid * NTHR + tid0; i < (size_t)TOK * DM / 4; i += NGT) ((f32x4*)a.out)[i] = f32x4{0.f, 0.f, 0.f, 0.f};
#endif
#undef IN
#undef SEAM
#undef modl
#undef MOD
#undef XN
#undef Qb
#undef Kb
#undef Vb
#undef UPb
#undef GAb
#undef GPb
#undef Mb
#undef QPb
#undef EIDX
#undef GSb
#undef EUb
#undef EVb
}

extern "C" void kernel_launch(void* const* d_in, const int* in_sizes, int n_in, void* d_out, int out_size, void* d_ws, size_t ws_size, hipStream_t stream) {
    static int grid = 0;
    if (grid == 0) {
        if (n_in != 19 || in_sizes[0] != TOK * DM || out_size != TOK * DM || ws_size < WS_END) {
            fprintf(stderr, "kernel_launch: unexpected shapes: n_in %d in0 %d out %d ws %zu (need %zu); nothing launched\n", n_in, n_in > 0 ? in_sizes[0] : -1, out_size, ws_size, (size_t)WS_END); grid = -1; return; }
        int dev = 0, cus = 0, per_cu = 0;
        if (hipGetDevice(&dev) != hipSuccess || hipDeviceGetAttribute(&cus, hipDeviceAttributeMultiprocessorCount, dev) != hipSuccess) { grid = -1; return; }
        if (hipFuncSetAttribute((const void*)mega, hipFuncAttributeMaxDynamicSharedMemorySize, LDS_BYTES) != hipSuccess) { fprintf(stderr, "kernel_launch: hipFuncSetAttribute failed\n"); grid = -1; return; }
        if (hipOccupancyMaxActiveBlocksPerMultiprocessor(&per_cu, (const void*)mega, NTHR, LDS_BYTES) != hipSuccess || per_cu < 1) {
            fprintf(stderr, "kernel_launch: occupancy query says %d blocks per CU; nothing launched\n", per_cu); (void)hipGetLastError(); grid = -1; return; }
        grid = cus;
    }
    if (grid < 0) return;
    (void)hipMemsetAsync((char*)d_ws + WS_CTL, 0, CTL_ZERO_BYTES, stream);
    Args a; memset(&a, 0, sizeof(a));
    const float** ap = (const float**)&a;
    for (int i = 0; i < 19; ++i) ap[i] = (const float*)d_in[i];
    a.out = (float*)d_out; a.ws = (unsigned char*)d_ws;
#if MK_ONE_LAUNCH
    a.ph_lo = 0; a.ph_hi = N_PHASES;
    hipLaunchKernelGGL(mega, dim3(grid), dim3(NTHR), LDS_BYTES, stream, a);
#else
    for (int p = 0; p < N_PHASES; ++p) {
        if (p == 1 + 11) continue;
        a.ph_lo = p; a.ph_hi = p + 1;
        hipLaunchKernelGGL(mega, dim3(grid), dim3(NTHR), LDS_BYTES, stream, a);
    }
#endif
    const hipError_t le = hipPeekAtLastError();
    if (le != hipSuccess) fprintf(stderr, "kernel_launch: launch failed: %s\n", hipGetErrorName(le));
}
```
